# Optimizing an MI355X kernel written in HIP

```python
import jax, jax.numpy as jnp
from jax import lax
import numpy as np

D_MODEL = 2048
BATCH = 16
SEQ = 2048
DEPTH = 2

GRID_W = 64
CTX_LEN = 256
MLA_HEADS = 8
QK_NOPE = 128
QK_ROPE = 64
V_HEAD = 128
Q_LORA = 512
KV_LORA = 512
N_FREQ = QK_ROPE // 4
ROPE_THETA = 10000.0
MLA_SCALE = (QK_NOPE + QK_ROPE) ** -0.5
Q_BLOCK = 128
NA_HEADS = 8
NA_HEAD_DIM = 128
WIN_H = 8
WIN_W = 16
NA_SCALE = NA_HEAD_DIM ** -0.5
D_MLA_OUT = MLA_HEADS * V_HEAD
D_NA = NA_HEADS * NA_HEAD_DIM
D_MIX = D_MLA_OUT + D_NA
P_IN = Q_LORA + KV_LORA + QK_ROPE + 3 * D_NA
D_FF = 5632
N_MOD = 9
EPS = 1e-6
NEG = -1e30

kernel_name = "hymba_mla_natten_macaron_dit"


def rms_norm(x, g):
    xf = x.astype(jnp.float32)
    y = xf * lax.rsqrt(jnp.mean(xf * xf, axis=-1, keepdims=True) + EPS)
    return (y * g.astype(jnp.float32)).astype(x.dtype)


def modulate(x, shift, scale):
    return x * (1 + scale) + shift


def swiglu(h, w1, w3, w2):
    return (jax.nn.silu(h @ w1) * (h @ w3)) @ w2


def axial_rope_tables(n_tokens):
    t = jnp.arange(n_tokens, dtype=jnp.int32)
    pos = jnp.stack([t // GRID_W, t % GRID_W], axis=-1).astype(jnp.float32)
    inv_freq = ROPE_THETA ** (-jnp.arange(N_FREQ, dtype=jnp.float32) / N_FREQ)
    ang = pos[:, :, None] * inv_freq
    return jnp.cos(ang), jnp.sin(ang)


def apply_axial_rope(x, cos, sin):
    lead = x.shape[:-1]
    xr = x.astype(jnp.float32).reshape(lead + (2, 2, N_FREQ))
    a, b = xr[..., 0, :], xr[..., 1, :]
    expand = (cos.shape[0],) + (1,) * (x.ndim - 3) + cos.shape[1:]
    cs, sn = cos.reshape(expand), sin.reshape(expand)
    out = jnp.stack([a * cs - b * sn, a * sn + b * cs], axis=-2)
    return out.reshape(x.shape).astype(x.dtype)


def mla_qkv(cq, ckv, qa_norm, w_uq, kva_norm, w_ukv):
    B, T = cq.shape[:2]
    q = (rms_norm(cq, qa_norm) @ w_uq).reshape(B, T, MLA_HEADS, QK_NOPE + QK_ROPE)
    kv = (rms_norm(ckv, kva_norm) @ w_ukv).reshape(B, T, MLA_HEADS, QK_NOPE + V_HEAD)
    return q[..., :QK_NOPE], q[..., QK_NOPE:], kv[..., :QK_NOPE], kv[..., QK_NOPE:]


def mla_attend(qn, qr, kn, kr, v):
    s = jnp.einsum('bqhd,bkhd->bhqk', qn, kn) + jnp.einsum('bqhr,bkr->bhqk', qr, kr)
    p = jax.nn.softmax(s.astype(jnp.float32) * MLA_SCALE, axis=-1).astype(v.dtype)
    return jnp.einsum('bhqk,bkhd->bqhd', p, v)


def mla_latent(qn, qr, kn, kr, v):
    B, S = qn.shape[:2]
    nb = S // Q_BLOCK

    def to_blocks(t):
        return jnp.moveaxis(t.reshape((B, nb, Q_BLOCK) + t.shape[2:]), 1, 0)

    o = lax.map(lambda qb: mla_attend(qb[0], qb[1], kn, kr, v), (to_blocks(qn), to_blocks(qr)))
    return jnp.moveaxis(o, 0, 1).reshape(B, S, D_MLA_OUT)


def dense_attention(q, k, v, scale):
    s = jnp.einsum('bqhd,bkhd->bhqk', q, k).astype(jnp.float32) * scale
    p = jax.nn.softmax(s, axis=-1).astype(v.dtype)
    return jnp.einsum('bhqk,bkhd->bqhd', p, v)


def natten_latent(q, k, v, k_c, v_c, rpb):
    B, S, H, Dh = q.shape
    rows = S // GRID_W
    wh = min(WIN_H, rows)
    qg = q.reshape(B, rows, GRID_W, H, Dh)
    kg = k.reshape(B, rows, GRID_W, H, Dh)
    vg = v.reshape(B, rows, GRID_W, H, Dh)
    cols = jnp.arange(GRID_W, dtype=jnp.int32)
    col_start = jnp.clip(cols - WIN_W // 2, 0, GRID_W - WIN_W)
    col_ok = (cols[None, :] >= col_start[:, None]) & (cols[None, :] < col_start[:, None] + WIN_W)
    mask = jnp.broadcast_to(col_ok[:, None, :], (GRID_W, wh, GRID_W)).reshape(GRID_W, wh * GRID_W)
    dc_idx = jnp.clip(cols[None, :] - cols[:, None] + WIN_W - 1, 0, 2 * WIN_W - 2)
    n_lat = wh * GRID_W

    def one_row(r):
        rs = jnp.clip(r - wh // 2, 0, rows - wh)
        q_r = lax.dynamic_index_in_dim(qg, r, axis=1, keepdims=False)
        k_s = lax.dynamic_slice_in_dim(kg, rs, wh, axis=1).reshape(B, n_lat, H, Dh)
        v_s = lax.dynamic_slice_in_dim(vg, rs, wh, axis=1).reshape(B, n_lat, H, Dh)
        dr_idx = rs + jnp.arange(wh, dtype=jnp.int32) - r + WIN_H - 1
        bias = rpb[:, dr_idx[:, None, None], dc_idx[None, :, :]]
        bias = bias.transpose(0, 2, 1, 3).reshape(H, GRID_W, n_lat).astype(jnp.float32)
        s_lat = jnp.einsum('bqhd,bkhd->bhqk', q_r, k_s).astype(jnp.float32) * NA_SCALE + bias
        s_lat = jnp.where(mask, s_lat, NEG)
        s_ctx = jnp.einsum('bqhd,bkhd->bhqk', q_r, k_c).astype(jnp.float32) * NA_SCALE
        p = jax.nn.softmax(jnp.concatenate([s_lat, s_ctx], axis=-1), axis=-1).astype(v.dtype)
        return (jnp.einsum('bhqk,bkhd->bqhd', p[..., :n_lat], v_s)
                + jnp.einsum('bhqk,bkhd->bqhd', p[..., n_lat:], v_c))

    o = lax.map(one_row, jnp.arange(rows, dtype=jnp.int32))
    return jnp.moveaxis(o, 0, 1).reshape(B, S, D_NA)


def split_in(p):
    i0 = Q_LORA
    i1 = i0 + KV_LORA
    i2 = i1 + QK_ROPE
    i3 = i2 + D_NA
    i4 = i3 + D_NA
    return jnp.split(p, [i0, i1, i2, i3, i4], axis=-1)


def merge_groups(a, b, out_norm, w_out):
    y = jnp.concatenate([rms_norm(a, out_norm[:D_MLA_OUT]), rms_norm(b, out_norm[D_MLA_OUT:])], axis=-1)
    return y @ w_out


def hybrid_mixer(h_lat, h_ctx, w_in, qa_norm, w_uq, kva_norm, w_ukv, rpb, out_norm, w_out, ctx_out):
    B, S, _ = h_lat.shape
    heads = lambda t: t.reshape(t.shape[0], t.shape[1], NA_HEADS, NA_HEAD_DIM)
    cq, ckv, kr, nq, nk, nv = split_in(h_lat @ w_in)
    cq_c, ckv_c, kr_c, nq_c, nk_c, nv_c = split_in(h_ctx @ w_in)
    qn, qr, kn, v = mla_qkv(cq, ckv, qa_norm, w_uq, kva_norm, w_ukv)
    qn_c, qr_c, kn_c, v_c = mla_qkv(cq_c, ckv_c, qa_norm, w_uq, kva_norm, w_ukv)
    cos, sin = axial_rope_tables(S)
    qr = apply_axial_rope(qr, cos, sin)
    kr = apply_axial_rope(kr, cos, sin)
    a_lat = mla_latent(qn, qr,
                       jnp.concatenate([kn, kn_c], axis=1),
                       jnp.concatenate([kr, kr_c], axis=1),
                       jnp.concatenate([v, v_c], axis=1))
    nk_c, nv_c = heads(nk_c), heads(nv_c)
    b_lat = natten_latent(heads(nq), heads(nk), heads(nv), nk_c, nv_c, rpb)
    y_lat = merge_groups(a_lat, b_lat, out_norm, w_out)
    if not ctx_out:
        return y_lat, None
    Bc, T = h_ctx.shape[:2]
    a_ctx = mla_attend(qn_c, qr_c, kn_c, kr_c, v_c).reshape(Bc, T, D_MLA_OUT)
    b_ctx = dense_attention(heads(nq_c), nk_c, nv_c, NA_SCALE).reshape(Bc, T, D_NA)
    return y_lat, merge_groups(a_ctx, b_ctx, out_norm, w_out)


def setup_inputs(seed: int = 0) -> dict:
    key = jax.random.key(seed)
    ks = iter(jax.random.split(key, 32))
    nrm = lambda shape, std: std * jax.random.normal(next(ks), shape, jnp.float32)
    gain = lambda shape: 1.0 + 0.01 * jax.random.normal(next(ks), shape, jnp.float32)
    L = DEPTH
    return {
        "x": nrm((BATCH, SEQ, D_MODEL), 1.0),
        "c": nrm((BATCH, D_MODEL), 1.0),
        "ctx": nrm((BATCH, CTX_LEN, D_MODEL), 1.0),
        "c_ctx": nrm((D_MODEL,), 1.0),
        "ada_w": nrm((L, D_MODEL, N_MOD * D_MODEL), 0.5 * D_MODEL ** -0.5),
        "ada_b": nrm((L, N_MOD * D_MODEL), 0.01),
        "ffn1_norm": gain((L, D_MODEL)),
        "ffn1_w1": nrm((L, D_MODEL, D_FF), D_MODEL ** -0.5),
        "ffn1_w3": nrm((L, D_MODEL, D_FF), D_MODEL ** -0.5),
        "ffn1_w2": nrm((L, D_FF, D_MODEL), D_FF ** -0.5),
        "mix_norm": gain((L, D_MODEL)),
        "w_in": nrm((L, D_MODEL, P_IN), D_MODEL ** -0.5),
        "qa_norm": gain((L, Q_LORA)),
        "w_uq": nrm((L, Q_LORA, MLA_HEADS * (QK_NOPE + QK_ROPE)), Q_LORA ** -0.5),
        "kva_norm": gain((L, KV_LORA)),
        "w_ukv": nrm((L, KV_LORA, MLA_HEADS * (QK_NOPE + V_HEAD)), KV_LORA ** -0.5),
        "na_rpb": nrm((L, NA_HEADS, 2 * WIN_H - 1, 2 * WIN_W - 1), 0.1),
        "out_norm": gain((L, D_MIX)),
        "w_out": nrm((L, D_MIX, D_MODEL), D_MIX ** -0.5),
        "ffn2_norm": gain((L, D_MODEL)),
        "ffn2_w1": nrm((L, D_MODEL, D_FF), D_MODEL ** -0.5),
        "ffn2_w3": nrm((L, D_MODEL, D_FF), D_MODEL ** -0.5),
        "ffn2_w2": nrm((L, D_FF, D_MODEL), D_FF ** -0.5),
        "final_norm": gain((D_MODEL,)),
    }


def reference(x, c, ctx, c_ctx, ada_w, ada_b, ffn1_norm, ffn1_w1, ffn1_w3, ffn1_w2, mix_norm, w_in,
              qa_norm, w_uq, kva_norm, w_ukv, na_rpb, out_norm, w_out, ffn2_norm, ffn2_w1, ffn2_w3,
              ffn2_w2, final_norm):
    s_lat = jax.nn.silu(c)[:, None, :]
    s_ctx = jax.nn.silu(c_ctx)[None, None, :]
    h, hc = x, ctx
    for l in range(DEPTH):
        last = l == DEPTH - 1
        m = jnp.split(s_lat @ ada_w[l] + ada_b[l], N_MOD, axis=-1)
        mc = jnp.split(s_ctx @ ada_w[l] + ada_b[l], N_MOD, axis=-1)
        h = h + 0.5 * m[2] * swiglu(modulate(rms_norm(h, ffn1_norm[l]), m[0], m[1]),
                                    ffn1_w1[l], ffn1_w3[l], ffn1_w2[l])
        hc = hc + 0.5 * mc[2] * swiglu(modulate(rms_norm(hc, ffn1_norm[l]), mc[0], mc[1]),
                                       ffn1_w1[l], ffn1_w3[l], ffn1_w2[l])
        y, yc = hybrid_mixer(modulate(rms_norm(h, mix_norm[l]), m[3], m[4]),
                             modulate(rms_norm(hc, mix_norm[l]), mc[3], mc[4]),
                             w_in[l], qa_norm[l], w_uq[l], kva_norm[l], w_ukv[l], na_rpb[l],
                             out_norm[l], w_out[l], not last)
        h = h + m[5] * y
        h = h + 0.5 * m[8] * swiglu(modulate(rms_norm(h, ffn2_norm[l]), m[6], m[7]),
                                    ffn2_w1[l], ffn2_w3[l], ffn2_w2[l])
        if not last:
            hc = hc + mc[5] * yc
            hc = hc + 0.5 * mc[8] * swiglu(modulate(rms_norm(hc, ffn2_norm[l]), mc[6], mc[7]),
                                           ffn2_w1[l], ffn2_w3[l], ffn2_w2[l])
    return rms_norm(h, final_norm)
```

```cpp
#include <hip/hip_runtime.h>
#include <cstdio>
#include <cstdint>

#ifndef MK_PER_PHASE
#define MK_PER_PHASE 0
#endif
#ifndef MK_DEBUG
#define MK_DEBUG 0
#endif

#define LAS __attribute__((address_space(3)))
#define GAS __attribute__((address_space(1)))
typedef unsigned short bf16_t;
typedef short bf16x8 __attribute__((ext_vector_type(8)));
typedef short s16x4 __attribute__((ext_vector_type(4)));
typedef float f32x2 __attribute__((ext_vector_type(2)));
typedef float f32x4 __attribute__((ext_vector_type(4)));
typedef float f32x16 __attribute__((ext_vector_type(16)));
typedef unsigned u32x2 __attribute__((ext_vector_type(2)));
typedef unsigned u32x4 __attribute__((ext_vector_type(4)));
typedef _Float16 f16x8 __attribute__((ext_vector_type(8)));

constexpr int D = 2048, NBATCH = 16, SEQ = 2048, CTXL = 256, DFF = 5632, DEPTH = 2;
constexpr int ML = NBATCH * SEQ, MC = NBATCH * CTXL, MT = ML + MC;
constexpr int NMOD = 9 * D;
constexpr int PIN = 4160, PINP = 4352;
constexpr int QW = 1536, KVW = 2048, UPW = QW + KVW;
constexpr float EPS = 1e-6f;
constexpr float MLA_SCALE = 0.07216878364870322f;
constexpr float NA_SCALE = 0.08838834764831845f;
constexpr int CV_I13 = (D / 64) * (2 * DFF / 32), CV_I2 = (DFF / 64) * (D / 32), CV_IIN = (D / 64) * (PINP / 32), CV_IUP = (512 / 64) * (UPW / 32), CV_IOUT = (D / 64) * (D / 32);
constexpr int CV_W13A = 0, CV_W2A = CV_I13, CV_W13B = CV_W2A + CV_I2, CV_W2B = CV_W13B + CV_I13, CV_WIN = CV_W2B + CV_I2, CV_WUP = CV_WIN + CV_IIN, CV_WOUT = CV_WUP + CV_IUP, CV_ALL = CV_WOUT + CV_IOUT;
constexpr int NPHASE = 20;

constexpr size_t MiB = 1u << 20;
constexpr size_t WS_CTL = 0, CTL_ZERO_BYTES = 1 * MiB;
constexpr size_t WS_MOD = 1 * MiB;
constexpr size_t WS_ROPE = 4 * MiB;
constexpr size_t WS_SMALL = WS_ROPE + 65536;
constexpr int SM_F1N = 0, SM_MIXN = 2 * D, SM_F2N = 4 * D, SM_OUTN = 6 * D, SM_FINN = 8 * D, SM_RPB = 9 * D, SM_TOTAL = 9 * D + 2 * 8 * 465;
constexpr size_t WS_RINV = 5 * MiB;
constexpr size_t WS_H16 = 6 * MiB;
constexpr size_t WS_W = 150 * MiB;
constexpr size_t WL_W13A = 0, WL_W2A = 44 * MiB, WL_W13B = 66 * MiB, WL_W2B = 110 * MiB, WL_WIN = 132 * MiB, WL_WUP = 149 * MiB, WL_WOUT = 153 * MiB, WL_SIZE = 161 * MiB;
constexpr size_t WS_XN = WS_W + WL_SIZE;
constexpr int XNP = D + 64;
constexpr size_t WS_BIG = WS_XN + 149 * MiB;
constexpr size_t BG_G = 0;
constexpr size_t BG_CQKV = 0, BG_NQKV = 72 * MiB, BG_KRF = 288 * MiB, BG_KR = 297 * MiB, BG_Q = 302 * MiB, BG_KV = 410 * MiB;
constexpr size_t WS_DBG = WS_BIG + 554 * MiB;
constexpr size_t WS_AO = WS_DBG + 1 * MiB;
constexpr size_t WS_SS = WS_AO + 144 * MiB;
constexpr size_t WS_CB = WS_SS + 2 * MiB;
constexpr int CB_S0 = 0, CB_S1 = 17 * 2 * DFF, CB_S2 = CB_S1 + 17 * PINP, CB_LAYER = CB_S2 + 17 * 2 * DFF;
constexpr size_t WS_END = WS_CB + 4 * MiB;
constexpr int CW_FIN = 135168;
constexpr int CW_SPK = 131072;
constexpr int CW_BAR = 4096;
constexpr int CW_DBG = 65536;

constexpr int RING_BYTES = 131072;
constexpr int SSL_OFF = RING_BYTES;
constexpr int LDSCTL_OFF = 143360, MISC_OFF = LDSCTL_OFF + 64;
constexpr int LDS_BYTES = 147456;

__device__ __forceinline__ unsigned cvt_pk_bf16(float lo, float hi) { unsigned r; asm volatile("v_cvt_pk_bf16_f32 %0, %1, %2" : "=v"(r) : "v"(lo), "v"(hi)); return r; }
__device__ __forceinline__ unsigned f2bf(float f) { unsigned u = __builtin_bit_cast(unsigned, f); return (u + 0x7fffu + ((u >> 16) & 1u)) >> 16; }
__device__ __forceinline__ float bf2f(unsigned b) { return __builtin_bit_cast(float, b << 16); }
typedef _Float16 f16x2 __attribute__((ext_vector_type(2)));
__device__ __forceinline__ unsigned cvt_pk_f16(float lo, float hi) { unsigned r; asm volatile("v_cvt_pk_f16_f32 %0, %1, %2" : "=v"(r) : "v"(lo), "v"(hi)); return r; }
typedef float f32x8 __attribute__((ext_vector_type(8)));
__device__ __forceinline__ void h8_to_f32(const u32x4 v, f32x4& lo, f32x4& hi) {
    const f32x8 f = __builtin_convertvector(__builtin_bit_cast(f16x8, v), f32x8);
    lo = (f32x4){f[0], f[1], f[2], f[3]}; hi = (f32x4){f[4], f[5], f[6], f[7]}; }
__device__ __forceinline__ int lane_now() { unsigned z = 0u; asm volatile("" : "+v"(z)); return (int)__builtin_amdgcn_mbcnt_hi(~0u, __builtin_amdgcn_mbcnt_lo(~0u, z)); }
__device__ __forceinline__ int opaque_tid(int wave) { return wave * 64 + lane_now(); }
__device__ __forceinline__ float shfl_xor_f(float v, int o, int lane) { return __builtin_bit_cast(float, __builtin_amdgcn_ds_bpermute((lane ^ o) << 2, __builtin_bit_cast(int, v))); }
__device__ __forceinline__ float wave_sum(float v, int lane) {
#pragma unroll
    for (int o = 1; o < 64; o <<= 1) v += shfl_xor_f(v, o, lane);
    return v;
}
__device__ __forceinline__ float silu_f(float x) { return x * __builtin_amdgcn_rcpf(1.0f + __builtin_amdgcn_exp2f(-1.4426950408889634f * x)); }
#define LDS_WAIT() asm volatile("s_waitcnt lgkmcnt(0)" ::: "memory")
#define VM_WAIT() asm volatile("s_waitcnt vmcnt(0)" ::: "memory")

#ifndef MK_SPK_SKEW
#define MK_SPK_SKEW 6
#endif
namespace pg8 {
constexpr int BM = 256, BK = 64, HALF = 128, HTB = HALF * BK * 2, STAGE_BYTES = 8 * HTB, NXCD = 8;
__host__ __device__ __forceinline__ int lds_byte(int r, int c) { const int st = (r >> 4) * 2 + (c >> 5), rr = r & 15, cc = c & 31, ob = rr * 64 + cc * 2; return st * 1024 + (ob ^ (((ob >> 9) & 1) << 5)); }
__host__ __device__ __forceinline__ void stage_rc(int b, int& R, int& C) { const int st = b / 1024, sb = b % 1024, swz = sb ^ (((sb >> 9) & 1) << 5); R = (st >> 1) * 16 + swz / 64; C = (st & 1) * 32 + (swz % 64) / 2; }
__host__ __device__ __forceinline__ int perm32(int rho) { const int n = rho >> 4, i = rho & 15; return 8 * (i >> 2) + 4 * n + (i & 3); }

struct Unit { int pm, pn, acol, tail; };
struct Gemm { const bf16_t* A; const bf16_t* Bt; int lda, ldb, K; };
struct Order {
    unsigned char* spk; int epoch;
    int nM, nN, nwg, G, c, split_pn, split_acol, WGM;
    __device__ void init(int nM_, int nN_, int G_, int c_, int wgm_, int split_pn_ = 1 << 30, int split_acol_ = 0) { nM = nM_; nN = nN_; nwg = nM * nN; G = G_; c = c_; WGM = wgm_; split_pn = split_pn_; split_acol = split_acol_; spk = nullptr; epoch = 0; }
    __device__ bool next(int i, Unit& u) const {
        long L = (long)i * G + c; u.tail = 0;
        if (epoch != 0 && i == nwg / G && (nwg % G) * 2 == G) {
            const int xcd = c % NXCD, off = c / NXCD, tl = (off >> 1) * NXCD + xcd;
            L = (long)i * G + tl; u.tail = (off & 1) ? -(tl + 1) : (tl + 1);
        } else if (L >= nwg) return false;
        int wgid = (int)L; { const int q = nwg / NXCD, r = nwg % NXCD, xcd = wgid % NXCD, off = wgid / NXCD; wgid = (xcd < r ? xcd * (q + 1) : r * (q + 1) + (xcd - r) * q) + off; }
        const int nig = WGM * nN, gid = wgid / nig, fm = gid * WGM, gsz = (nM - fm) < WGM ? (nM - fm) : WGM;
        u.pm = fm + ((wgid % nig) % gsz); u.pn = (wgid % nig) / gsz; u.acol = (u.pn >= split_pn) ? split_acol : 0; return true;
    }
};

template <class Epi, bool ALIGN_EPI, bool SP2, bool SPK = false>
__device__ __forceinline__ void gemm_phase(LAS unsigned char* lds, const int wave, const Gemm g, const Order& S, const Epi& E) {
    const int tid = opaque_tid(wave), wid = __builtin_amdgcn_readfirstlane(tid >> 6), lane = tid & 63, wr = wid >> 2, wc = wid & 3, fr = lane & 15, fq = lane >> 4;
    const int K = g.K, nt = K / BK;
    unsigned voffA[2], voffB[2];
#pragma unroll
    for (int i = 0; i < 2; ++i) { int R, C; stage_rc(tid * 16 + i * 8192, R, C); const int Rb = Epi::PERM ? ((R & ~31) + perm32(R & 31)) : R;
        voffA[i] = (unsigned)(R * g.lda + C) * 2u; voffB[i] = (unsigned)(Rb * g.ldb + C) * 2u; }
    const size_t kstep = (size_t)(BK * 2);
    const size_t hstepA = (size_t)HALF * g.lda * 2, hstepB = (size_t)HALF * g.ldb * 2;
    const size_t tstepA = 2 * hstepA, tstepB = 2 * hstepB;
    const unsigned ldsw = (unsigned)wid * 1024u;
    const int aoff = lds_byte(wr * 64 + fr, fq * 8), boff = lds_byte(wc * 32 + fr, fq * 8);
#define PG8_SA(b, h) (((b) * 2 + (h)) * HTB)
#define PG8_SB(b, h) ((4 + (b) * 2 + (h)) * HTB)
#define PG8_STAGE(bufoff, gbase, voff) do { _Pragma("unroll") for (int _i = 0; _i < 2; ++_i) \
        __builtin_amdgcn_global_load_lds((const unsigned*)((const char*)(gbase) + (voff)[_i]), (LAS unsigned*)(lds + (bufoff) + ldsw + _i * 8192), 16, 0, 0); } while (0)
#define PG8_LDA(dst, b, h) do { _Pragma("unroll") for (int m = 0; m < 4; ++m) _Pragma("unroll") for (int k = 0; k < 2; ++k) dst[m][k] = *(const LAS bf16x8*)(lds + PG8_SA(b, h) + aoff + m * 2048 + k * 1024); } while (0)
#define PG8_LDB(dst, b, h) do { _Pragma("unroll") for (int n = 0; n < 2; ++n) _Pragma("unroll") for (int k = 0; k < 2; ++k) dst[n][k] = *(const LAS bf16x8*)(lds + PG8_SB(b, h) + boff + n * 2048 + k * 1024); } while (0)
#define PG8_MMA(ai, bj, At, Bt) do { __builtin_amdgcn_s_setprio(1); _Pragma("unroll") for (int m = 0; m < 4; ++m) _Pragma("unroll") for (int n = 0; n < 2; ++n) _Pragma("unroll") for (int k = 0; k < 2; ++k) \
        acc[ai][bj][m][n] = __builtin_amdgcn_mfma_f32_16x16x32_bf16(Bt[n][k], At[m][k], acc[ai][bj][m][n], 0, 0, 0); __builtin_amdgcn_s_setprio(0); } while (0)
#define PG8_WAIT_V(n) asm volatile("s_waitcnt vmcnt(" #n ")" ::: "memory")
#define PG8_WAIT_L(n) asm volatile("s_waitcnt lgkmcnt(" #n ")" ::: "memory")
#define PG8_BAR __builtin_amdgcn_s_barrier()
#define PG8_SCHED __builtin_amdgcn_sched_barrier(0)
    Unit cur, nxt; int ui = 0;
    if (!S.next(0, cur)) return;
    f32x4 acc[2][2][4][2];
#pragma unroll
    for (int a = 0; a < 2; ++a)
#pragma unroll
        for (int b = 0; b < 2; ++b)
#pragma unroll
            for (int m = 0; m < 4; ++m)
#pragma unroll
                for (int n = 0; n < 2; ++n) acc[a][b][m][n] = (f32x4){0.f, 0.f, 0.f, 0.f};
    bf16x8 At[4][2], B0[2][2], B1[2][2];
    const int ntb = ((nt >> 1) - (SPK ? MK_SPK_SKEW : 0)) & ~1;
#define PG8_KOFS(u) ((SPK && (u).tail > 0) ? (size_t)ntb * kstep : (size_t)0)
    const char* cA = (const char*)g.A + (size_t)cur.pm * tstepA + (size_t)cur.acol * 2 + PG8_KOFS(cur); const char* cB = (const char*)g.Bt + (size_t)cur.pn * tstepB + PG8_KOFS(cur);
    E.panel_setup(cur, -1, tid);
    typename Epi::Pre pre = E.pre_load(cur, tid);
    int prev_pm = -1;
    if constexpr (SP2) {
        PG8_STAGE(PG8_SB(0, 0), cB, voffB); PG8_STAGE(PG8_SB(0, 1), cB + hstepB, voffB); PG8_STAGE(PG8_SA(0, 0), cA, voffA); PG8_STAGE(PG8_SA(0, 1), cA + hstepA, voffA);
        if (wr == 1) PG8_BAR;
        PG8_WAIT_V(2); PG8_BAR;
        PG8_STAGE(PG8_SB(1, 0), cB + kstep, voffB); PG8_STAGE(PG8_SA(1, 0), cA + kstep, voffA); PG8_STAGE(PG8_SB(1, 1), cB + hstepB + kstep, voffB);
        PG8_WAIT_V(6); PG8_BAR;
    } else {
        PG8_STAGE(PG8_SB(0, 0), cB, voffB); PG8_STAGE(PG8_SA(0, 0), cA, voffA); PG8_STAGE(PG8_SB(0, 1), cB + hstepB, voffB); PG8_STAGE(PG8_SA(0, 1), cA + hstepA, voffA);
        if (wr == 1) PG8_BAR;
        PG8_WAIT_V(4); PG8_BAR;
        PG8_STAGE(PG8_SB(1, 0), cB + kstep, voffB); PG8_STAGE(PG8_SA(1, 0), cA + kstep, voffA); PG8_STAGE(PG8_SB(1, 1), cB + hstepB + kstep, voffB);
        PG8_WAIT_V(6); PG8_BAR;
    }
    for (;;) {
        const bool has_next = S.next(ui + 1, nxt);
        const char* nA = has_next ? (const char*)g.A + (size_t)nxt.pm * tstepA + (size_t)nxt.acol * 2 + PG8_KOFS(nxt) : cA; const char* nB = has_next ? (const char*)g.Bt + (size_t)nxt.pn * tstepB + PG8_KOFS(nxt) : cB;
        const int ntu = (SPK && cur.tail != 0) ? (cur.tail > 0 ? nt - ntb : ntb) : nt;
        for (int t = 0; t < ntu; t += 2) {
            const bool last = (t == ntu - 2);
            const char* a1 = cA + (size_t)(t + 1) * kstep;
            const char* a2 = last ? nA : cA + (size_t)(t + 2) * kstep; const char* b2 = last ? nB : cB + (size_t)(t + 2) * kstep;
            const char* a3 = a2 + kstep; const char* b3 = b2 + kstep;
            if constexpr (Epi::MIDSCALE) { if (t == nt / 2) E.mid(acc, wr, fr); }
            if constexpr (SP2) {
            PG8_LDB(B0, 0, 0); PG8_LDB(B1, 0, 1); PG8_SCHED; PG8_LDA(At, 0, 0); PG8_STAGE(PG8_SA(1, 1), a1 + hstepA, voffA);
            PG8_WAIT_V(8); PG8_WAIT_L(0); PG8_BAR; PG8_MMA(0, 0, At, B0); PG8_MMA(0, 1, At, B1); PG8_BAR; PG8_SCHED;
            PG8_LDA(At, 0, 1); PG8_STAGE(PG8_SB(0, 0), b2, voffB); PG8_STAGE(PG8_SB(0, 1), b2 + hstepB, voffB); PG8_STAGE(PG8_SA(0, 0), a2, voffA);
            PG8_WAIT_V(8); PG8_WAIT_L(0); PG8_BAR; PG8_MMA(1, 0, At, B0); PG8_MMA(1, 1, At, B1); PG8_BAR; PG8_SCHED;
            PG8_LDB(B0, 1, 0); PG8_LDB(B1, 1, 1); PG8_SCHED; PG8_LDA(At, 1, 0); PG8_STAGE(PG8_SA(0, 1), a2 + hstepA, voffA);
            PG8_WAIT_V(8); PG8_WAIT_L(0); PG8_BAR; PG8_MMA(0, 0, At, B0); PG8_MMA(0, 1, At, B1); PG8_BAR; PG8_SCHED;
            PG8_LDA(At, 1, 1); PG8_STAGE(PG8_SB(1, 0), b3, voffB); PG8_STAGE(PG8_SB(1, 1), b3 + hstepB, voffB); PG8_STAGE(PG8_SA(1, 0), a3, voffA);
            PG8_WAIT_V(8); PG8_WAIT_L(0); PG8_BAR; PG8_MMA(1, 0, At, B0); PG8_MMA(1, 1, At, B1); PG8_BAR; PG8_SCHED;
            } else {
            PG8_LDB(B0, 0, 0); PG8_SCHED; PG8_LDA(At, 0, 0); PG8_STAGE(PG8_SA(1, 1), a1 + hstepA, voffA);
            PG8_WAIT_L(8); PG8_BAR; PG8_WAIT_L(0); PG8_MMA(0, 0, At, B0); PG8_BAR; PG8_SCHED;
            PG8_LDB(B1, 0, 1); PG8_STAGE(PG8_SB(0, 0), b2, voffB);
            PG8_BAR; PG8_WAIT_L(0); PG8_MMA(0, 1, At, B1); PG8_BAR;
            PG8_LDA(At, 0, 1); PG8_STAGE(PG8_SA(0, 0), a2, voffA);
            PG8_BAR; PG8_WAIT_L(0); PG8_MMA(1, 0, At, B0); PG8_BAR; PG8_SCHED;
            PG8_STAGE(PG8_SB(0, 1), b2 + hstepB, voffB);
            PG8_WAIT_V(6); PG8_BAR; PG8_MMA(1, 1, At, B1); PG8_BAR;
            PG8_LDB(B0, 1, 0); PG8_SCHED; PG8_LDA(At, 1, 0); PG8_STAGE(PG8_SA(0, 1), a2 + hstepA, voffA);
            PG8_WAIT_L(8); PG8_BAR; PG8_WAIT_L(0); PG8_MMA(0, 0, At, B0); PG8_BAR; PG8_SCHED;
            PG8_LDB(B1, 1, 1); PG8_STAGE(PG8_SB(1, 0), b3, voffB);
            PG8_BAR; PG8_WAIT_L(0); PG8_MMA(0, 1, At, B1); PG8_BAR;
            PG8_LDA(At, 1, 1); PG8_STAGE(PG8_SA(1, 0), a3, voffA);
            PG8_BAR; PG8_WAIT_L(0); PG8_MMA(1, 0, At, B0); PG8_BAR; PG8_SCHED;
            PG8_STAGE(PG8_SB(1, 1), b3 + hstepB, voffB);
            PG8_WAIT_V(6); PG8_BAR; PG8_MMA(1, 1, At, B1); PG8_BAR;
            }
        }
        if constexpr (ALIGN_EPI) { if (wr == 0) PG8_BAR; }
        if constexpr (SPK) {
            if (cur.tail > 0) {
                unsigned* flag = (unsigned*)(S.spk + WS_CTL) + CW_SPK + (cur.tail - 1) * 16;
                if (wave == 0 && lane_now() == 0) { for (unsigned spins = 0; spins < (1u << 22) && __hip_atomic_load(flag, __ATOMIC_RELAXED, __HIP_MEMORY_SCOPE_AGENT) != (unsigned)S.epoch; ++spins) __builtin_amdgcn_s_sleep(2);
                    __builtin_amdgcn_fence(__ATOMIC_ACQUIRE, "agent"); asm volatile("s_waitcnt vmcnt(0)" ::: "memory"); }
                __syncthreads();
            }
        }
        E(acc, cur, pre, prev_pm, wr, wc, fr, fq);
        if constexpr (SPK) {
            if (cur.tail < 0) {
                unsigned* flag = (unsigned*)(S.spk + WS_CTL) + CW_SPK + (-cur.tail - 1) * 16;
                asm volatile("s_waitcnt vmcnt(0)" ::: "memory");
                __syncthreads();
                if (wave == 0 && lane_now() == 0) { __builtin_amdgcn_fence(__ATOMIC_RELEASE, "agent"); asm volatile("s_waitcnt vmcnt(0)" ::: "memory"); __hip_atomic_store(flag, (unsigned)S.epoch, __ATOMIC_RELAXED, __HIP_MEMORY_SCOPE_AGENT); }
            }
        }
        prev_pm = cur.pm;
        if (!has_next) break;
        E.panel_setup(nxt, prev_pm, tid);
        pre = E.pre_load(nxt, tid);
#pragma unroll
        for (int a = 0; a < 2; ++a)
#pragma unroll
            for (int b = 0; b < 2; ++b)
#pragma unroll
                for (int m = 0; m < 4; ++m)
#pragma unroll
                    for (int n = 0; n < 2; ++n) acc[a][b][m][n] = (f32x4){0.f, 0.f, 0.f, 0.f};
        cur = nxt; cA = nA; cB = nB; ++ui;
        if constexpr (ALIGN_EPI) { if (wr == 1) PG8_BAR; }
    }
    PG8_WAIT_V(0);
    if constexpr (!ALIGN_EPI) { if (wr == 0) PG8_BAR; }
    PG8_BAR;
#undef PG8_KOFS
#undef PG8_SA
#undef PG8_SB
#undef PG8_STAGE
#undef PG8_LDA
#undef PG8_LDB
#undef PG8_MMA
#undef PG8_WAIT_V
#undef PG8_WAIT_L
#undef PG8_BAR
#undef PG8_SCHED
}

struct PreNone { };
struct PreSS { f32x4 v; };
__device__ __forceinline__ PreSS ss_pre_load(const float* SS, const Unit& u, int tid) { PreSS p; p.v = *(const f32x4*)(SS + ((size_t)u.pm * BM + (tid >> 1)) * 8 + (tid & 1) * 4); return p; }
__device__ __forceinline__ void rinv_from_pre(const PreSS& p, bool rebuild, int wr, int wc, int fr, int fq, float (&ri)[8]) {
    LAS float* sl = (LAS float*)(uintptr_t)SSL_OFF;
    if (rebuild) {
        const int t = (wr * 4 + wc) * 64 + fq * 16 + fr;
        asm volatile("s_waitcnt lgkmcnt(0)" ::: "memory"); __builtin_amdgcn_s_barrier(); asm volatile("" ::: "memory");
        sl[t] = (p.v[0] + p.v[1]) + (p.v[2] + p.v[3]);
        asm volatile("s_waitcnt lgkmcnt(0)" ::: "memory"); __builtin_amdgcn_s_barrier(); asm volatile("" ::: "memory");
    }
#pragma unroll
    for (int q = 0; q < 8; ++q) { const f32x2 s = *(const LAS f32x2*)(sl + (wr * 64 + fr + (q >> 2) * HALF + (q & 3) * 16) * 2); ri[q] = __builtin_amdgcn_rsqf((s[0] + s[1]) * (1.0f / D) + EPS); }
}
struct EpiSwiGLU {
    static constexpr bool PERM = true, MIDSCALE = false; typedef PreSS Pre;
    __device__ __forceinline__ void panel_setup(const Unit&, int, int) const {}
    bf16_t* G; int ldg; const float* SS; const float* cb;
    __device__ __forceinline__ Pre pre_load(const Unit& u, int tid) const { return ss_pre_load(SS, u, tid); }
    __device__ __forceinline__ void operator()(f32x4 (&acc)[2][2][4][2], const Unit& u, const Pre& pre, int prev_pm, int wr, int wc, int fr, int fq) const {
        const int row0 = u.pm * BM + wr * 64 + fr, col0 = u.pn * HALF + wc * 32 + 8 * fq;
        const int b = (u.pm < ML / BM) ? (u.pm >> 3) : 16;
        const float* cp = cb + (size_t)b * (2 * DFF) + u.pn * BM + wc * 32 + 8 * fq;
        const f32x4 ca0 = *(const f32x4*)cp, ca1 = *(const f32x4*)(cp + 4), cb0 = *(const f32x4*)(cp + HALF), cb1 = *(const f32x4*)(cp + HALF + 4);
        float rinv[8]; rinv_from_pre(pre, u.pm != prev_pm, wr, wc, fr, fq, rinv);
#pragma unroll
        for (int ai = 0; ai < 2; ++ai)
#pragma unroll
            for (int m = 0; m < 4; ++m) {
                const int row = row0 + ai * HALF + m * 16;
                const float ri = rinv[ai * 4 + m];
                bf16_t* rowp = G + (size_t)row * ldg + col0;
                const f32x4 a0 = acc[ai][0][m][0] * ri + ca0, a1 = acc[ai][0][m][1] * ri + ca1, b0 = acc[ai][1][m][0] * ri + cb0, b1 = acc[ai][1][m][1] * ri + cb1;
                float g[8];
#pragma unroll
                for (int i = 0; i < 4; ++i) { g[i] = silu_f(a0[i]) * b0[i]; g[4 + i] = silu_f(a1[i]) * b1[i]; }
                u32x4 w; w.x = cvt_pk_bf16(g[0], g[1]); w.y = cvt_pk_bf16(g[2], g[3]); w.z = cvt_pk_bf16(g[4], g[5]); w.w = cvt_pk_bf16(g[6], g[7]);
                *(u32x4*)rowp = w;
            }
    }
};
template <bool MS> struct EpiResid {
    static constexpr bool PERM = true, MIDSCALE = MS; typedef PreNone Pre;
    __device__ __forceinline__ Pre pre_load(const Unit&, int) const { return Pre{}; }
    __device__ __forceinline__ void panel_setup(const Unit& u, int prev_pm, int tid) const {
        if constexpr (MS) { if (u.pm != prev_pm || u.tail < 0) {
            LAS f32x2* tb = (LAS f32x2*)(uintptr_t)(SSL_OFF + 8192);
            asm volatile("s_waitcnt lgkmcnt(0)" ::: "memory"); __builtin_amdgcn_s_barrier(); asm volatile("" : "+v"(tid) :: "memory");
            if (tid < BM) { const float* sp = (const float*)(ws + WS_BIG + BG_KRF) + ((size_t)u.pm * BM + tid) * 16;
                const f32x4 a0 = *(const f32x4*)sp, a1 = *(const f32x4*)(sp + 4), b0 = *(const f32x4*)(sp + 8), b1 = *(const f32x4*)(sp + 12);
                const float ra = __builtin_amdgcn_rsqf((((a0[0] + a0[1]) + (a0[2] + a0[3])) + ((a1[0] + a1[1]) + (a1[2] + a1[3]))) * (1.0f / 1024.f) + EPS);
                const float rb = __builtin_amdgcn_rsqf((((b0[0] + b0[1]) + (b0[2] + b0[3])) + ((b1[0] + b1[1]) + (b1[2] + b1[3]))) * (1.0f / 1024.f) + EPS);
                tb[tid] = (f32x2){ra / rb, u.tail < 0 ? ra : rb}; }
            asm volatile("s_waitcnt lgkmcnt(0)" ::: "memory"); __builtin_amdgcn_s_barrier(); asm volatile("" ::: "memory");
        } }
    }
    __device__ __forceinline__ void mid(f32x4 (&acc)[2][2][4][2], int wr, int fr) const {
        const LAS f32x2* tb = (const LAS f32x2*)(uintptr_t)(SSL_OFF + 8192);
#pragma unroll
        for (int ai = 0; ai < 2; ++ai)
#pragma unroll
            for (int m = 0; m < 4; ++m) { const float r = tb[wr * 64 + fr + ai * HALF + m * 16][0];
#pragma unroll
                for (int bj = 0; bj < 2; ++bj) { acc[ai][bj][m][0] *= r; acc[ai][bj][m][1] *= r; } }
    }
    unsigned char* ws; float* out;
    int l, gidx; float scale; int emit, nvec, ln, sidxn, dst_out;
    __device__ __forceinline__ void operator()(f32x4 (&acc)[2][2][4][2], const Unit& u, const Pre&, int, int wr, int wc, int fr, int fq) const {
        const int emit_ = (u.tail < 0) ? 0 : emit;
        unsigned char* w_ = ws; float* o_ = out; asm volatile("" : "+s"(w_), "+s"(o_));
        { const int ln_ = lane_now(); fr = ln_ & 15; fq = ln_ >> 4; }
        const float* modl = (const float*)(w_ + WS_MOD) + (size_t)l * 17 * NMOD; const float* modn = (const float*)(w_ + WS_MOD) + (size_t)ln * 17 * NMOD;
        const float* gn = (const float*)(w_ + WS_SMALL) + nvec; float* SS = (float*)(w_ + WS_SS);
        LAS float* ssl = (LAS float*)(uintptr_t)SSL_OFF;
        const bool lat = u.pm < ML / BM;
        const int b = lat ? (u.pm >> 3) : 16;
        const float* gate = modl + (size_t)b * NMOD + gidx * D;
        const int col0 = u.pn * BM + wc * 32 + 8 * fq, r0 = wr * 64 + fr;
        const unsigned e0 = (unsigned)(r0 * D + col0);
        GAS char* hb = (GAS char*)(w_ + WS_H16) + (size_t)u.pm * BM * D * 2;
        GAS char* xnb = (GAS char*)(w_ + WS_XN) + (size_t)u.pm * BM * XNP * 2;
        const unsigned e0x = (unsigned)(r0 * XNP + col0);
        GAS float* ob = (GAS float*)o_ + (size_t)u.pm * BM * D;
        if constexpr (MS) { const LAS f32x2* tb = (const LAS f32x2*)(uintptr_t)(SSL_OFF + 8192);
#pragma unroll
            for (int ai = 0; ai < 2; ++ai)
#pragma unroll
                for (int m = 0; m < 4; ++m) { const float r = tb[r0 + ai * HALF + m * 16][1];
#pragma unroll
                    for (int bj = 0; bj < 2; ++bj) { acc[ai][bj][m][0] *= r; acc[ai][bj][m][1] *= r; } } }
#pragma unroll
        for (int bj = 0; bj < 2; ++bj) {
            const int c = col0 + bj * HALF;
            const f32x4 gv0 = *(const f32x4*)(gate + c) * scale, gv1 = *(const f32x4*)(gate + c + 4) * scale;
#pragma unroll
            for (int ai = 0; ai < 2; ++ai) {
                u32x4 s[4];
#pragma unroll
                for (int m = 0; m < 4; ++m) s[m] = *(const GAS u32x4*)((hb + (size_t)(((ai * HALF + m * 16) * D + bj * HALF) * 2)) + e0 * 2u);
#pragma unroll
                for (int m = 0; m < 4; ++m) { f32x4 s0, s1; h8_to_f32(s[m], s0, s1);
                    acc[ai][bj][m][0] = s0 + gv0 * acc[ai][bj][m][0]; acc[ai][bj][m][1] = s1 + gv1 * acc[ai][bj][m][1]; }
            }
            asm volatile("" ::: "memory");
        }
        if (dst_out) {
            float sq[8];
#pragma unroll
            for (int q = 0; q < 8; ++q) { sq[q] = 0.f;
#pragma unroll
                for (int bj = 0; bj < 2; ++bj) { const f32x4 h0 = acc[q >> 2][bj][q & 3][0], h1 = acc[q >> 2][bj][q & 3][1];
                    sq[q] += ((h0[0] * h0[0] + h0[1] * h0[1]) + (h0[2] * h0[2] + h0[3] * h0[3])) + ((h1[0] * h1[0] + h1[1] * h1[1]) + (h1[2] * h1[2] + h1[3] * h1[3])); } }
            { const int ln2 = lane_now(), r0b = wr * 64 + (ln2 & 15);
#pragma unroll
              for (int q = 0; q < 8; ++q) { float v = sq[q]; v += shfl_xor_f(v, 16, ln2); v += shfl_xor_f(v, 32, ln2); if (ln2 < 16) ssl[(r0b + (q >> 2) * HALF + (q & 3) * 16) * 4 + wc] = v; } }
            asm volatile("s_waitcnt lgkmcnt(0)" ::: "memory"); __builtin_amdgcn_s_barrier(); asm volatile("" ::: "memory");
            const int t = (wr * 4 + wc) * 64 + lane_now();
            if (t < BM) { const f32x4 p = *(const LAS f32x4*)(ssl + t * 4); SS[((size_t)u.pm * BM + t) * 8 + u.pn] = (p[0] + p[1]) + (p[2] + p[3]); }
            asm volatile("s_waitcnt vmcnt(0)" ::: "memory");
            __syncthreads();
            if (t == 0) { unsigned* cnt = (unsigned*)(w_ + WS_CTL) + CW_FIN + u.pm * 16;
                __builtin_amdgcn_fence(__ATOMIC_RELEASE, "agent"); asm volatile("s_waitcnt vmcnt(0)" ::: "memory");
                __hip_atomic_fetch_add(cnt, 1u, __ATOMIC_RELAXED, __HIP_MEMORY_SCOPE_AGENT);
                for (unsigned spins = 0; spins < (1u << 22) && __hip_atomic_load(cnt, __ATOMIC_RELAXED, __HIP_MEMORY_SCOPE_AGENT) < 8u; ++spins) __builtin_amdgcn_s_sleep(2);
                __builtin_amdgcn_fence(__ATOMIC_ACQUIRE, "agent"); asm volatile("s_waitcnt vmcnt(0)" ::: "memory"); }
            __syncthreads();
            if (t < BM) { const float* sp = SS + ((size_t)u.pm * BM + t) * 8; const f32x4 a = *(const f32x4*)sp, b2 = *(const f32x4*)(sp + 4);
                ssl[t] = 1.0f / sqrtf((((a[0] + a[1]) + (a[2] + a[3])) + ((b2[0] + b2[1]) + (b2[2] + b2[3]))) * (1.0f / D) + EPS); }
            asm volatile("s_waitcnt lgkmcnt(0)" ::: "memory"); __builtin_amdgcn_s_barrier(); asm volatile("" ::: "memory");
            const float* gf = (const float*)(w_ + WS_SMALL) + SM_FINN;
            float ri[8];
            { const int r0c = wr * 64 + (lane_now() & 15);
#pragma unroll
              for (int q = 0; q < 8; ++q) ri[q] = ssl[r0c + (q >> 2) * HALF + (q & 3) * 16]; }
#pragma unroll
            for (int bj = 0; bj < 2; ++bj) { const int c = col0 + bj * HALF; const f32x4 g0 = *(const f32x4*)(gf + c), g1 = *(const f32x4*)(gf + c + 4);
#pragma unroll
                for (int q = 0; q < 8; ++q) { const size_t co = (size_t)(((q >> 2) * HALF + (q & 3) * 16) * D + bj * HALF);
                    const f32x4 h0 = acc[q >> 2][bj][q & 3][0] * ri[q] * g0, h1 = acc[q >> 2][bj][q & 3][1] * ri[q] * g1;
                    *(GAS f32x4*)((GAS char*)(ob + co) + e0 * 4u) = h0; *(GAS f32x4*)((GAS char*)(ob + co + 4) + e0 * 4u) = h1; } }
            return;
        }
        float ssq[8];
#pragma unroll
        for (int q = 0; q < 8; ++q) ssq[q] = 0.f;
#pragma unroll
        for (int bj = 0; bj < 2; ++bj) {
            f32x4 gs0 = (f32x4){0.f, 0.f, 0.f, 0.f}, gs1 = gs0;
            if (emit_) { const int c = col0 + bj * HALF; const float* mp = modn + (size_t)b * NMOD + sidxn * D + c; gs0 = *(const f32x4*)(gn + c) * (*(const f32x4*)mp + 1.0f); gs1 = *(const f32x4*)(gn + c + 4) * (*(const f32x4*)(mp + 4) + 1.0f); }
#pragma unroll
            for (int q = 0; q < 8; ++q) { const size_t co = (size_t)(((q >> 2) * HALF + (q & 3) * 16) * D + bj * HALF);
                const f32x4 h0 = acc[q >> 2][bj][q & 3][0], h1 = acc[q >> 2][bj][q & 3][1];
                { u32x4 hv; hv.x = cvt_pk_f16(h0[0], h0[1]); hv.y = cvt_pk_f16(h0[2], h0[3]); hv.z = cvt_pk_f16(h1[0], h1[1]); hv.w = cvt_pk_f16(h1[2], h1[3]); *(GAS u32x4*)((hb + co * 2) + e0 * 2u) = hv; }
                if (emit_) { ssq[q] += ((h0[0] * h0[0] + h0[1] * h0[1]) + (h0[2] * h0[2] + h0[3] * h0[3])) + ((h1[0] * h1[0] + h1[1] * h1[1]) + (h1[2] * h1[2] + h1[3] * h1[3]));
                    const f32x4 a0 = h0 * gs0, a1 = h1 * gs1;
                    u32x4 w; w.x = cvt_pk_bf16(a0[0], a0[1]); w.y = cvt_pk_bf16(a0[2], a0[3]); w.z = cvt_pk_bf16(a1[0], a1[1]); w.w = cvt_pk_bf16(a1[2], a1[3]); *(GAS u32x4*)((xnb + (size_t)(((q >> 2) * HALF + (q & 3) * 16) * XNP + bj * HALF) * 2) + e0x * 2u) = w; } }
        }
        if (emit_) {
#pragma unroll
            for (int q = 0; q < 8; ++q) { float v = ssq[q]; v += shfl_xor_f(v, 16, fq * 16 + fr); v += shfl_xor_f(v, 32, fq * 16 + fr); if (fq == 0) ssl[(r0 + (q >> 2) * HALF + (q & 3) * 16) * 4 + wc] = v; }
        }
        if (emit_) {
            asm volatile("s_waitcnt lgkmcnt(0)" ::: "memory"); __builtin_amdgcn_s_barrier(); asm volatile("" ::: "memory");
            const int t = (wr * 4 + wc) * 64 + fq * 16 + fr;
            if (t < BM) { const f32x4 p = *(const LAS f32x4*)(ssl + t * 4); SS[((size_t)u.pm * BM + t) * 8 + u.pn] = (p[0] + p[1]) + (p[2] + p[3]); }
        }
    }
};
template <bool P> struct EpiNull {
    static constexpr bool PERM = P, MIDSCALE = false; typedef PreNone Pre;
    __device__ __forceinline__ void panel_setup(const Unit&, int, int) const {}
    __device__ __forceinline__ Pre pre_load(const Unit&, int) const { return Pre{}; }
    __device__ __forceinline__ void operator()(f32x4 (&acc)[2][2][4][2], const Unit&, const Pre&, int, int, int, int, int) const {
#pragma unroll
        for (int ai = 0; ai < 2; ++ai)
#pragma unroll
            for (int bj = 0; bj < 2; ++bj) asm volatile("" :: "v"(acc[ai][bj][0][0]), "v"(acc[ai][bj][0][1]), "v"(acc[ai][bj][1][0]), "v"(acc[ai][bj][1][1]), "v"(acc[ai][bj][2][0]), "v"(acc[ai][bj][2][1]), "v"(acc[ai][bj][3][0]), "v"(acc[ai][bj][3][1]));
    }
};
struct EpiWin {
    static constexpr bool PERM = true, MIDSCALE = false; typedef PreSS Pre;
    __device__ __forceinline__ void panel_setup(const Unit&, int, int) const {}
    bf16_t* CQKV; bf16_t* NQKV; bf16_t* KR; float* SSQ4; const float* SS; const float* cb; const float* cosT;
    __device__ __forceinline__ Pre pre_load(const Unit& u, int tid) const { return ss_pre_load(SS, u, tid); }
    __device__ __forceinline__ void operator()(f32x4 (&acc)[2][2][4][2], const Unit& u, const Pre& pre, int prev_pm, int wr, int wc, int fr, int fq) const {
        const int row0 = u.pm * BM + wr * 64 + fr;
        const int b = (u.pm < ML / BM) ? (u.pm >> 3) : 16;
        const float* cp = cb + (size_t)b * PINP + u.pn * BM + wc * 32 + 8 * fq;
        f32x4 cv[2][2];
#pragma unroll
        for (int bj = 0; bj < 2; ++bj)
#pragma unroll
            for (int n = 0; n < 2; ++n) cv[bj][n] = *(const f32x4*)(cp + bj * HALF + 4 * n);
        bf16_t* base = CQKV; int colt = u.pn * BM;
        if (u.pn >= 4) { const int t = (u.pn - 4) >> 2; base = NQKV + (size_t)t * MT * 1024; colt = ((u.pn - 4) & 3) * BM; }
        const int col0 = colt + wc * 32 + 8 * fq;
        float rinv[8]; rinv_from_pre(pre, u.pm != prev_pm, wr, wc, fr, fq, rinv);
        LAS float* sq = (LAS float*)(uintptr_t)(SSL_OFF + 4096);
#pragma unroll
        for (int ai = 0; ai < 2; ++ai)
#pragma unroll
            for (int m = 0; m < 4; ++m) { const int row = row0 + ai * HALF + m * 16;
                const float ri = rinv[ai * 4 + m];
                if (u.pn < 16) { bf16_t* rowp = base + (size_t)row * 1024 + col0; float ssq = 0.f;
#pragma unroll
                    for (int bj = 0; bj < 2; ++bj) { const f32x4 v0 = acc[ai][bj][m][0] * ri + cv[bj][0], v1 = acc[ai][bj][m][1] * ri + cv[bj][1];
                        ssq += ((v0[0] * v0[0] + v0[1] * v0[1]) + (v0[2] * v0[2] + v0[3] * v0[3])) + ((v1[0] * v1[0] + v1[1] * v1[1]) + (v1[2] * v1[2] + v1[3] * v1[3]));
                        u32x4 w; w.x = cvt_pk_bf16(v0[0], v0[1]); w.y = cvt_pk_bf16(v0[2], v0[3]); w.z = cvt_pk_bf16(v1[0], v1[1]); w.w = cvt_pk_bf16(v1[2], v1[3]);
                        *(u32x4*)(rowp + bj * HALF) = w; }
                    if (u.pn < 4) { ssq += shfl_xor_f(ssq, 16, fq * 16 + fr); ssq += shfl_xor_f(ssq, 32, fq * 16 + fr); if (fq == 0) sq[(wr * 64 + fr + ai * HALF + m * 16) * 4 + wc] = ssq; }
                } else if (wc < 2) {
                    f32x4 a = acc[ai][0][m][0] * ri + cv[0][0], bq = acc[ai][0][m][1] * ri + cv[0][1];
                    if (u.pm < ML / BM) { const int t = row & (SEQ - 1); const int pos = wc ? (t & 63) : (t >> 6);
                        const f32x4 cs = *(const f32x4*)(cosT + pos * 16 + 4 * fq), sn = *(const f32x4*)(cosT + 1024 + pos * 16 + 4 * fq);
                        const f32x4 a2 = a * cs - bq * sn, b2 = a * sn + bq * cs; a = a2; bq = b2; }
                    u32x4 w; w.x = cvt_pk_bf16(a[0], a[1]); w.y = cvt_pk_bf16(a[2], a[3]); w.z = cvt_pk_bf16(bq[0], bq[1]); w.w = cvt_pk_bf16(bq[2], bq[3]);
                    *(u32x4*)(KR + (size_t)row * 64 + wc * 32 + 8 * fq) = w; }
            }
        if (u.pn < 4) {
            asm volatile("s_waitcnt lgkmcnt(0)" ::: "memory"); __builtin_amdgcn_s_barrier(); asm volatile("" ::: "memory");
            const int t = (wr * 4 + wc) * 64 + fq * 16 + fr;
            if (t < BM) { const f32x4 p = *(const LAS f32x4*)(sq + t * 4); SSQ4[((size_t)u.pm * BM + t) * 4 + u.pn] = (p[0] + p[1]) + (p[2] + p[3]); }
        }
    }
};
struct EpiUp {
    static constexpr bool PERM = true, MIDSCALE = false; typedef PreNone Pre;
    __device__ __forceinline__ void panel_setup(const Unit&, int, int) const {}
    bf16_t* Q; bf16_t* KV; const float* SSQ4; const float* cosT; const float* sinT;
    __device__ __forceinline__ Pre pre_load(const Unit&, int) const { return Pre{}; }
    __device__ __forceinline__ void operator()(f32x4 (&acc)[2][2][4][2], const Unit& u, const Pre&, int, int wr, int wc, int fr, int fq) const {
        const int row0 = u.pm * BM + wr * 64 + fr;
        const bool isq = u.pn < 6; const bool lat = u.pm < ML / BM;
        bf16_t* base = isq ? Q : KV; const int ld = isq ? QW : KVW; const int colt = isq ? u.pn * BM : (u.pn - 6) * BM;
        const int col0 = colt + wc * 32 + 8 * fq;
#pragma unroll
        for (int ai = 0; ai < 2; ++ai)
#pragma unroll
            for (int m = 0; m < 4; ++m) { const int row = row0 + ai * HALF + m * 16; const f32x2 sq2 = *(const f32x2*)(SSQ4 + (size_t)row * 4 + (isq ? 0 : 2)); const float ri = __builtin_amdgcn_rsqf((sq2[0] + sq2[1]) * (1.0f / 512.f) + EPS);
                bf16_t* rowp = base + (size_t)row * ld + col0;
#pragma unroll
                for (int bj = 0; bj < 2; ++bj) { f32x4 v0 = acc[ai][bj][m][0] * ri, v1 = acc[ai][bj][m][1] * ri;
                    const int c32 = (u.pn * 8 + bj * 4 + wc) % 6;
                    if (isq && lat && c32 >= 4) { const int t = row & (SEQ - 1); const int pos = (c32 == 4) ? (t >> 6) : (t & 63);
                        const f32x4 cs = *(const f32x4*)(cosT + pos * 16 + 4 * fq), sn = *(const f32x4*)(sinT + pos * 16 + 4 * fq);
                        const f32x4 a = v0, b = v1; v0 = a * cs - b * sn; v1 = a * sn + b * cs; }
                    u32x4 w; w.x = cvt_pk_bf16(v0[0], v0[1]); w.y = cvt_pk_bf16(v0[2], v0[3]); w.z = cvt_pk_bf16(v1[0], v1[1]); w.w = cvt_pk_bf16(v1[2], v1[3]);
                    *(u32x4*)(rowp + bj * HALF) = w; } }
    }
};
}

namespace att {
constexpr int KN_B = 16384, KR_B = 8192, V_B = 16384, SLOT = KN_B + KR_B + V_B, NSLOT = 3;
constexpr int KN_OFF = 0, KR_OFF = KN_B, V_OFF = KN_B + KR_B;
constexpr int SCR_OFF = NSLOT * SLOT;
constexpr int BIAS_OFF = SCR_OFF + 2048;
constexpr int OST_OFF = BIAS_OFF + 2048;
static_assert(OST_OFF + 8 * 2048 <= LDSCTL_OFF, "attention LDS");
constexpr float THR = 8.f;
#define SBAR() __builtin_amdgcn_sched_barrier(0)
__device__ __forceinline__ int crow(int r, int hi) { return (r & 3) + 8 * (r >> 2) + 4 * hi; }

__device__ __forceinline__ void partialSM(f32x16& p0, f32x16& p1, float& m_reg, float& mn, float& alpha, const float C, const float thr) {
    float pmax = p0[0];
#pragma unroll
    for (int r = 1; r < 16; ++r) pmax = fmaxf(pmax, p0[r]);
#pragma unroll
    for (int r = 0; r < 16; ++r) pmax = fmaxf(pmax, p1[r]);
    { auto rr = __builtin_amdgcn_permlane32_swap(__float_as_uint(pmax), __float_as_uint(pmax), false, false);
      pmax = fmaxf(__uint_as_float(rr[0]), __uint_as_float(rr[1])); }
    if (__builtin_expect(__all(pmax - m_reg <= thr), 1)) { mn = m_reg; alpha = 1.f; }
    else { mn = fmaxf(m_reg, pmax); alpha = __builtin_amdgcn_exp2f((m_reg - mn) * C); m_reg = mn; }
    const float mnC = -mn * C;
#pragma unroll
    for (int r = 0; r < 16; ++r) p0[r] = __builtin_amdgcn_exp2f(fmaf(p0[r], C, mnC));
#pragma unroll
    for (int r = 0; r < 16; ++r) p1[r] = __builtin_amdgcn_exp2f(fmaf(p1[r], C, mnC));
}
__device__ __forceinline__ void finishSM(const f32x16& p0, const f32x16& p1, float alpha, float& l_reg, bf16x8& pa0, bf16x8& pa1, bf16x8& pa2, bf16x8& pa3) {
    float ps = 0;
#pragma unroll
    for (int r = 0; r < 16; ++r) ps += p0[r];
#pragma unroll
    for (int r = 0; r < 16; ++r) ps += p1[r];
    { auto rr = __builtin_amdgcn_permlane32_swap(__float_as_uint(ps), __float_as_uint(ps), false, false);
      ps = __uint_as_float(rr[0]) + __uint_as_float(rr[1]); }
    l_reg = l_reg * alpha + ps;
#define PK4(P, BASE, OUT) do { unsigned a0 = cvt_pk_bf16(P[BASE + 0], P[BASE + 1]), a1 = cvt_pk_bf16(P[BASE + 2], P[BASE + 3]);   \
    unsigned b0 = cvt_pk_bf16(P[BASE + 4], P[BASE + 5]), b1 = cvt_pk_bf16(P[BASE + 6], P[BASE + 7]);                              \
    auto r0 = __builtin_amdgcn_permlane32_swap(a0, b0, false, false); auto r1 = __builtin_amdgcn_permlane32_swap(a1, b1, false, false); \
    u32x4 w = {r0[0], r1[0], r0[1], r1[1]}; OUT = __builtin_bit_cast(bf16x8, w); } while (0)
    PK4(p0, 0, pa0); PK4(p0, 8, pa1); PK4(p1, 0, pa2); PK4(p1, 8, pa3);
#undef PK4
}
__device__ __forceinline__ int v_rd_base(int lane) { return ((lane & 3) << 3) | (((lane >> 2) & 3) << 6) | (((lane >> 4) & 1) << 5) | (((lane >> 5) & 1) << 8); }
constexpr int v_rd_off(int d0, int ks, int half) { return d0 * 512 + ks * 4096 + half * 2048; }
template <int OFF> __device__ __forceinline__ s16x4 tr_read(unsigned vb) {
    s16x4 r; asm volatile("ds_read_b64_tr_b16 %0, %1 offset:%2" : "=&v"(r) : "v"(vb), "i"(OFF) : "memory"); return r;
}
template <int D0> __device__ __forceinline__ void pv_one(f32x16& od, unsigned vb, bf16x8 pa0, bf16x8 pa1, bf16x8 pa2, bf16x8 pa3) {
    const s16x4 l0 = tr_read<v_rd_off(D0, 0, 0)>(vb), h0 = tr_read<v_rd_off(D0, 0, 1)>(vb), l1 = tr_read<v_rd_off(D0, 1, 0)>(vb), h1 = tr_read<v_rd_off(D0, 1, 1)>(vb);
    const s16x4 l2 = tr_read<v_rd_off(D0, 2, 0)>(vb), h2 = tr_read<v_rd_off(D0, 2, 1)>(vb), l3 = tr_read<v_rd_off(D0, 3, 0)>(vb), h3 = tr_read<v_rd_off(D0, 3, 1)>(vb);
    asm volatile("s_waitcnt lgkmcnt(0)" ::: "memory"); SBAR();
#define PK(L, H) (bf16x8){L[0], L[1], L[2], L[3], H[0], H[1], H[2], H[3]}
    od = __builtin_amdgcn_mfma_f32_32x32x16_bf16(pa0, PK(l0, h0), od, 0, 0, 0);
    od = __builtin_amdgcn_mfma_f32_32x32x16_bf16(pa1, PK(l1, h1), od, 0, 0, 0);
    od = __builtin_amdgcn_mfma_f32_32x32x16_bf16(pa2, PK(l2, h2), od, 0, 0, 0);
    od = __builtin_amdgcn_mfma_f32_32x32x16_bf16(pa3, PK(l3, h3), od, 0, 0, 0);
#undef PK
}
__device__ __forceinline__ int swap23(int k) { return (k & ~0xC) | ((k & 4) << 1) | ((k & 8) >> 1); }

template <int DQK, bool NA>
__device__ __forceinline__ void attn_unit(LAS unsigned char* lds, const int wave,
        const bf16_t* __restrict__ Qp, const int ldq, const bf16_t* __restrict__ Knb, const bf16_t* __restrict__ Vb, const int ldkv, const bf16_t* __restrict__ Krb,
        const int base1, const int n1, const int base2, const int n2, const float scale, bf16_t* __restrict__ Op, const int ldo,
        const float* __restrict__ rpb_h, const int strip0, const int qgr0, float* __restrict__ ssa  ) {
    constexpr int ND = DQK / 16;
    const int tid = opaque_tid(wave), lane = tid & 63, wid = __builtin_amdgcn_readfirstlane(tid >> 6);
    const int r32 = lane & 31, hi = lane >> 5;
    LAS float* wsf = (LAS float*)(lds + SCR_OFF) + wid * 64; LAS float* li_l = wsf; LAS float* al_l = wsf + 32;
    LAS float* bias_l = (LAS float*)(lds + BIAS_OFF);
    unsigned okn[2], ov[2], okr;
#pragma unroll
    for (int i = 0; i < 2; ++i) { const int q = i * 512 + tid; const int row = q >> 4, cs = q & 15; okn[i] = (unsigned)(row * ldkv * 2 + ((cs ^ (row & 15)) << 4)); }
#pragma unroll
    for (int i = 0; i < 2; ++i) { const int q = i * 512 + tid; const int sub = q >> 5; const int kk = (sub >> 2) * 8 + ((q & 31) >> 2), c = (sub & 3) * 32 + (q & 3) * 8; ov[i] = (unsigned)(swap23(kk) * ldkv * 2 + c * 2); }
    { const int q = tid; const int row = q >> 3, cs = q & 7; okr = (unsigned)(row * 128 + ((cs ^ ((row >> 1) & 7)) << 4)); }
    const int nt = n1 + n2;
    __syncthreads();
    if (NA) { for (int i = tid; i < 465; i += 512) bias_l[i] = rpb_h[i]; }
    bf16x8 qr[ND];
    { const bf16_t* Qw = Qp + (size_t)(wid * 32 + r32) * ldq + hi * 8;
#pragma unroll
      for (int d0 = 0; d0 < ND; ++d0) qr[d0] = *(const bf16x8*)(Qw + d0 * 16); }
#define ATT_TROW(j_) ((j_) < n1 ? base1 + 64 * (j_) : base2 + 64 * ((j_) - n1))
#define ATT_ISSUE(j_, slot_) do { const size_t tr_ = (size_t)ATT_TROW(j_); LAS unsigned char* sl_ = lds + (slot_) * SLOT + wid * 1024; \
        const char* kb_ = (const char*)Knb + tr_ * (size_t)ldkv * 2; const char* vb_ = (const char*)Vb + tr_ * (size_t)ldkv * 2; \
        __builtin_amdgcn_global_load_lds((const unsigned*)(kb_ + okn[0]), (LAS unsigned*)(sl_ + KN_OFF), 16, 0, 0); \
        __builtin_amdgcn_global_load_lds((const unsigned*)(kb_ + okn[1]), (LAS unsigned*)(sl_ + KN_OFF + 8192), 16, 0, 0); \
        __builtin_amdgcn_global_load_lds((const unsigned*)(vb_ + ov[0]), (LAS unsigned*)(sl_ + V_OFF), 16, 0, 0); \
        __builtin_amdgcn_global_load_lds((const unsigned*)(vb_ + ov[1]), (LAS unsigned*)(sl_ + V_OFF + 8192), 16, 0, 0); \
        if (DQK == 192) __builtin_amdgcn_global_load_lds((const unsigned*)((const char*)Krb + tr_ * 128 + okr), (LAS unsigned*)(sl_ + KR_OFF), 16, 0, 0); } while (0)
    if (NA) { ATT_ISSUE(0, 0); if (nt > 1) ATT_ISSUE(1, 1); } else { ATT_ISSUE(0, 0); }
    float m_reg = -1e30f, l_reg = 0.f;
    f32x16 o[4];
#pragma unroll
    for (int d = 0; d < 4; ++d)
#pragma unroll
        for (int r = 0; r < 16; ++r) o[d][r] = 0.f;
    const int gr = qgr0 + (wid >> 1), rs = min(max(gr - 4, 0), 24);
    const int qc = (wid & 1) * 32 + r32, cs0 = min(max(qc - 8, 0), 48);
    const unsigned lds_u = (unsigned)(unsigned long)lds;
    if constexpr (!NA) {
        const float C = scale * 1.4426950408889634f, thr = THR / scale;
        f32x16 pA0, pA1, pB0, pB1; float alA = 1.f, alB = 1.f, mnT;
#define T15_QK(sb_, P0, P1) do { \
            _Pragma("unroll") for (int r = 0; r < 16; ++r) { P0[r] = 0.f; P1[r] = 0.f; } \
            bf16x8 kf0[2], kf1[2]; \
            const unsigned ka = (sb_) + KN_OFF + r32 * 256, kx = (unsigned)((r32 & 15) << 4); \
            const unsigned ra = (sb_) + KR_OFF + r32 * 128, rx = (unsigned)((r32 >> 1) & 7); \
            kf0[0] = *(const LAS bf16x8*)(ka + ((unsigned)(hi * 16) ^ kx)); kf1[0] = *(const LAS bf16x8*)(ka + 32 * 256 + ((unsigned)(hi * 16) ^ kx)); \
            _Pragma("unroll") for (int d0 = 0; d0 < ND; ++d0) { \
                if (d0 + 1 < 8) { const unsigned cb = (unsigned)(((d0 + 1) * 16 + hi * 8) * 2) ^ kx; kf0[(d0 + 1) & 1] = *(const LAS bf16x8*)(ka + cb); kf1[(d0 + 1) & 1] = *(const LAS bf16x8*)(ka + 32 * 256 + cb); } \
                else if (d0 + 1 < ND) { const unsigned ch = ((unsigned)((d0 + 1 - 8) * 2 + hi) ^ rx) << 4; kf0[(d0 + 1) & 1] = *(const LAS bf16x8*)(ra + ch); kf1[(d0 + 1) & 1] = *(const LAS bf16x8*)(ra + 32 * 128 + ch); } \
                P0 = __builtin_amdgcn_mfma_f32_32x32x16_bf16(kf0[d0 & 1], qr[d0], P0, 0, 0, 0); \
                P1 = __builtin_amdgcn_mfma_f32_32x32x16_bf16(kf1[d0 & 1], qr[d0], P1, 0, 0, 0); } } while (0)
#define T15_RESC(a_) do { if (__any((a_) < 1.f)) { if (hi == 0) al_l[r32] = (a_); asm volatile("s_waitcnt lgkmcnt(0)" ::: "memory"); \
            _Pragma("unroll") for (int r = 0; r < 16; ++r) { const float a = al_l[crow(r, hi)]; _Pragma("unroll") for (int d = 0; d < 4; ++d) o[d][r] *= a; } } } while (0)
#define T15_TOP(j_, sn_) do { asm volatile("s_waitcnt vmcnt(0)" ::: "memory"); asm volatile("s_waitcnt lgkmcnt(0)" ::: "memory"); __builtin_amdgcn_s_barrier(); asm volatile("" ::: "memory"); \
            if ((j_) + 1 < nt) ATT_ISSUE((j_) + 1, sn_); } while (0)
#define T15_STEP(j_, sc_, so_, sn_, PN0, PN1, AN, PO0, PO1, AO) do { \
            T15_TOP(j_, sn_); \
            bf16x8 pa0, pa1, pa2, pa3; \
            SBAR(); T15_QK(lds_u + (sc_) * SLOT, PN0, PN1); finishSM(PO0, PO1, AO, l_reg, pa0, pa1, pa2, pa3); SBAR(); \
            { const unsigned vb = lds_u + (so_) * SLOT + V_OFF + v_rd_base(lane); \
              pv_one<0>(o[0], vb, pa0, pa1, pa2, pa3); pv_one<1>(o[1], vb, pa0, pa1, pa2, pa3); pv_one<2>(o[2], vb, pa0, pa1, pa2, pa3); pv_one<3>(o[3], vb, pa0, pa1, pa2, pa3); } \
            partialSM(PN0, PN1, m_reg, mnT, AN, C, thr); \
            T15_RESC(AN); } while (0)
        T15_TOP(0, 1);
        T15_QK(lds_u, pA0, pA1); partialSM(pA0, pA1, m_reg, mnT, alA, C, thr); T15_RESC(alA);
        int sc = 1, so = 0, sn = 2;
        for (int j = 1; j < nt; j += 2) {
            T15_STEP(j, sc, so, sn, pB0, pB1, alB, pA0, pA1, alA);
            { const int t = so; so = sc; sc = sn; sn = t; }
            if (j + 1 < nt) {
                T15_STEP(j + 1, sc, so, sn, pA0, pA1, alA, pB0, pB1, alB);
                { const int t = so; so = sc; sc = sn; sn = t; }
            }
        }
        {
            bf16x8 pa0, pa1, pa2, pa3;
            if ((nt & 1) == 0) finishSM(pB0, pB1, alB, l_reg, pa0, pa1, pa2, pa3); else finishSM(pA0, pA1, alA, l_reg, pa0, pa1, pa2, pa3);
            const unsigned vb = lds_u + so * SLOT + V_OFF + v_rd_base(lane);
            pv_one<0>(o[0], vb, pa0, pa1, pa2, pa3); pv_one<1>(o[1], vb, pa0, pa1, pa2, pa3); pv_one<2>(o[2], vb, pa0, pa1, pa2, pa3); pv_one<3>(o[3], vb, pa0, pa1, pa2, pa3);
        }
#undef T15_QK
#undef T15_RESC
#undef T15_TOP
#undef T15_STEP
    } else {
    int slot = 0, slot2 = 2;
    for (int j = 0; j < nt; ++j) {
        if (j + 1 < nt) { if (DQK == 192) asm volatile("s_waitcnt vmcnt(5)" ::: "memory"); else asm volatile("s_waitcnt vmcnt(4)" ::: "memory"); }
        else asm volatile("s_waitcnt vmcnt(0)" ::: "memory");
        asm volatile("s_waitcnt lgkmcnt(0)" ::: "memory");
        __builtin_amdgcn_s_barrier();
        asm volatile("" ::: "memory");
        if (j + 2 < nt) ATT_ISSUE(j + 2, slot2);
        bool active = true; int dr = 0;
        if (NA && j < n1) { const int kr = strip0 + j; active = (kr >= rs) && (kr < rs + 8); dr = kr - gr + 7; }
        if (active) {
            const unsigned sb = lds_u + slot * SLOT;
            f32x16 p0, p1;
#pragma unroll
            for (int r = 0; r < 16; ++r) { p0[r] = 0.f; p1[r] = 0.f; }
            {
                bf16x8 kf0[2], kf1[2];
                const unsigned ka = sb + KN_OFF + r32 * 256, kx = (unsigned)((r32 & 15) << 4);
                const unsigned ra = sb + KR_OFF + r32 * 128, rx = (unsigned)((r32 >> 1) & 7);
                kf0[0] = *(const LAS bf16x8*)(ka + ((unsigned)(hi * 16) ^ kx)); kf1[0] = *(const LAS bf16x8*)(ka + 32 * 256 + ((unsigned)(hi * 16) ^ kx));
#pragma unroll
                for (int d0 = 0; d0 < ND; ++d0) {
                    if (d0 + 1 < 8) { const unsigned cb = (unsigned)(((d0 + 1) * 16 + hi * 8) * 2) ^ kx; kf0[(d0 + 1) & 1] = *(const LAS bf16x8*)(ka + cb); kf1[(d0 + 1) & 1] = *(const LAS bf16x8*)(ka + 32 * 256 + cb); }
                    else if (d0 + 1 < ND) { const unsigned ch = ((unsigned)((d0 + 1 - 8) * 2 + hi) ^ rx) << 4; kf0[(d0 + 1) & 1] = *(const LAS bf16x8*)(ra + ch); kf1[(d0 + 1) & 1] = *(const LAS bf16x8*)(ra + 32 * 128 + ch); }
                    p0 = __builtin_amdgcn_mfma_f32_32x32x16_bf16(kf0[d0 & 1], qr[d0], p0, 0, 0, 0);
                    p1 = __builtin_amdgcn_mfma_f32_32x32x16_bf16(kf1[d0 & 1], qr[d0], p1, 0, 0, 0);
                }
            }
            float mn, alpha;
            if (NA) {
                if (j < n1) {
                    const LAS float* brow = bias_l + dr * 31 - qc + 15;
#pragma unroll
                    for (int r = 0; r < 16; ++r) { const int kc = crow(r, hi); const bool v0 = (unsigned)(kc - cs0) < 16u, v1 = (unsigned)(kc + 32 - cs0) < 16u;
                        const float b0 = brow[v0 ? kc : qc], b1 = brow[v1 ? kc + 32 : qc];
                        p0[r] = v0 ? fmaf(p0[r], scale, b0) : -1e30f; p1[r] = v1 ? fmaf(p1[r], scale, b1) : -1e30f; }
                } else {
#pragma unroll
                    for (int r = 0; r < 16; ++r) { p0[r] *= scale; p1[r] *= scale; }
                }
                partialSM(p0, p1, m_reg, mn, alpha, 1.4426950408889634f, THR);
            } else {
                partialSM(p0, p1, m_reg, mn, alpha, scale * 1.4426950408889634f, THR / scale);
            }
            if (__any(alpha < 1.f)) { if (hi == 0) al_l[r32] = alpha; asm volatile("s_waitcnt lgkmcnt(0)" ::: "memory");
#pragma unroll
                for (int r = 0; r < 16; ++r) { const float a = al_l[crow(r, hi)];
#pragma unroll
                    for (int d = 0; d < 4; ++d) o[d][r] *= a; } }
            bf16x8 pa0, pa1, pa2, pa3;
            finishSM(p0, p1, alpha, l_reg, pa0, pa1, pa2, pa3);
            const unsigned vb = sb + V_OFF + v_rd_base(lane);
            pv_one<0>(o[0], vb, pa0, pa1, pa2, pa3); pv_one<1>(o[1], vb, pa0, pa1, pa2, pa3); pv_one<2>(o[2], vb, pa0, pa1, pa2, pa3); pv_one<3>(o[3], vb, pa0, pa1, pa2, pa3);
        }
        slot = (slot == 2) ? 0 : slot + 1; slot2 = (slot2 == 2) ? 0 : slot2 + 1;
    }
    }
    if (hi == 0) li_l[r32] = l_reg; asm volatile("s_waitcnt lgkmcnt(0)" ::: "memory");
    LAS unsigned char* ost = lds + OST_OFF + wid * 2048;
    bf16_t* Ow = Op + (size_t)(wid * 32) * ldo;
#pragma unroll
    for (int g = 0; g < 4; ++g) {
#pragma unroll
        for (int rr = 0; rr < 4; ++rr) { const int r = 4 * g + rr; const int orow = crow(r, hi); const float rl = __builtin_amdgcn_rcpf(li_l[orow]);
#pragma unroll
            for (int d0 = 0; d0 < 4; ++d0) *(LAS bf16_t*)(ost + ((orow & 7) * 128 + d0 * 32 + r32) * 2) = (bf16_t)f2bf(o[d0][r] * rl); }
        asm volatile("s_waitcnt lgkmcnt(0)" ::: "memory");
#pragma unroll
        for (int h = 0; h < 2; ++h) { const int ch = lane + 64 * h; const u32x4 v = *(const LAS u32x4*)(ost + ch * 16);
            *(u32x4*)(Ow + (size_t)(8 * g + (ch >> 4)) * ldo + (ch & 15) * 8) = v;
            float sq = 0.f;
#pragma unroll
            for (int i = 0; i < 4; ++i) { const float x0 = bf2f(v[i] & 0xffffu), x1 = bf2f(v[i] >> 16); sq += x0 * x0 + x1 * x1; }
            sq += shfl_xor_f(sq, 1, lane); sq += shfl_xor_f(sq, 2, lane); sq += shfl_xor_f(sq, 4, lane); sq += shfl_xor_f(sq, 8, lane);
            if ((ch & 15) == 0) ssa[(size_t)(wid * 32 + 8 * g + (ch >> 4)) * 16] = sq; }
        asm volatile("s_waitcnt lgkmcnt(0)" ::: "memory");
    }
#undef ATT_TROW
#undef ATT_ISSUE
}
}

#define XB_TMO      128
#define XB_XCNT(j)  (256  + 64 * (j))
#define XB_XSUB(j)  (1280 + 64 * (j))
#define XB_XGEN(j)  (2304 + 64 * (j))
#define XB_TOP      3328
#define XB_TOPGEN   3392
#define XCD_BAR_WORDS 3456
#define XB_SPIN_CAP (1u << 18)
__device__ __forceinline__ unsigned xb_ld(unsigned* p)              { return __hip_atomic_load(p, __ATOMIC_RELAXED, __HIP_MEMORY_SCOPE_AGENT); }
__device__ __forceinline__ unsigned xb_add(unsigned* p, unsigned v) { return __hip_atomic_fetch_add(p, v, __ATOMIC_RELAXED, __HIP_MEMORY_SCOPE_AGENT); }
__device__ __forceinline__ unsigned xb_xcc_id() { return (unsigned)__builtin_amdgcn_s_getreg((3 << 11) | 20) & 0xFu; }
#define XB_SPIN(cond, bar) do { unsigned _sp = 0; while (cond) { __builtin_amdgcn_s_sleep(1); \
    if ((++_sp & 255u) == 0u) { if (xb_ld(&(bar)[XB_TMO])) break; if (_sp > XB_SPIN_CAP) { atomicAdd(&(bar)[XB_TMO], 1u); break; } } } } while (0)
struct XcdBarrier { unsigned* bar; unsigned x; volatile LAS unsigned* st; int wave; };
__device__ __forceinline__ XcdBarrier xcd_barrier_post(unsigned* bar, volatile LAS unsigned* st) {
    XcdBarrier b; b.bar = bar; b.x = xb_xcc_id(); b.st = st; b.wave = 0;
    if (threadIdx.x == 0) (void)xb_add(&bar[XB_XCNT(b.x)], 1u);
    return b;
}
__device__ __forceinline__ void xcd_barrier_complete(unsigned* bar, unsigned x, unsigned& nloc, unsigned& nx) {
    const unsigned G = gridDim.x * gridDim.y * gridDim.z;
    unsigned sum, cnt, mine, sp = 0u;
    for (;;) {
        sum = 0u; cnt = 0u; mine = 0u;
#pragma unroll
        for (unsigned j = 0; j < 16; ++j) { const unsigned c = xb_ld(&bar[XB_XCNT(j)]); sum += c; cnt += (c > 0u) ? 1u : 0u; mine = (j == x) ? c : mine; }
        if (sum == G) break;
        __builtin_amdgcn_s_sleep(1);
        if ((++sp & 255u) == 0u) { if (xb_ld(&bar[XB_TMO])) break; if (sp > XB_SPIN_CAP) { atomicAdd(&bar[XB_TMO], 1u); break; } }
    }
    nloc = mine > 0u ? mine : 1u; nx = cnt > 0u ? cnt : 1u;
}
__device__ __forceinline__ void xcd_barrier(const XcdBarrier& b) {
    asm volatile("s_waitcnt vmcnt(0)" ::: "memory");
    __syncthreads();
    if (b.wave == 0 && lane_now() == 0) {
        unsigned* bar = b.bar; unsigned bx_ = b.x; asm volatile("" : "+s"(bar), "+s"(bx_));
        __builtin_amdgcn_s_waitcnt(0);
        unsigned nloc = b.st[0], nx = b.st[1];
        if (nloc == 0u) { xcd_barrier_complete(bar, bx_, nloc, nx); b.st[0] = nloc; b.st[1] = nx; }
        const unsigned old = xb_add(&bar[XB_XSUB(bx_)], 1u);
        const unsigned gen = old / nloc;
        if (old + 1u == (gen + 1u) * nloc) {
            __builtin_amdgcn_fence(__ATOMIC_RELEASE, "agent");
            asm volatile("s_waitcnt vmcnt(0)" ::: "memory");
            const unsigned og = xb_add(&bar[XB_TOP], 1u);
            const unsigned tg = og / nx;
            if (og + 1u == (tg + 1u) * nx) xb_add(&bar[XB_TOPGEN], 1u);
            else XB_SPIN(xb_ld(&bar[XB_TOPGEN]) == tg, bar);
            __builtin_amdgcn_fence(__ATOMIC_ACQUIRE, "agent");
            xb_add(&bar[XB_XGEN(bx_)], 1u);
            asm volatile("s_waitcnt vmcnt(0)" ::: "memory");
        } else {
            XB_SPIN(xb_ld(&bar[XB_XGEN(bx_)]) == gen, bar);
            __builtin_amdgcn_fence(__ATOMIC_ACQUIRE, "agent");
            asm volatile("s_waitcnt vmcnt(0)" ::: "memory");
        }
    }
    __syncthreads();
}

struct Args { const float* in[24]; float* out; unsigned char* ws; int ph_lo, ph_hi; };
enum { I_X = 0, I_C, I_CTX, I_CCTX, I_ADAW, I_ADAB, I_F1N, I_F1W1, I_F1W3, I_F1W2, I_MIXN, I_WIN, I_QAN, I_WUQ, I_KVAN, I_WUKV, I_RPB, I_OUTN, I_WOUT, I_F2N, I_F2W1, I_F2W3, I_F2W2, I_FINN };
struct Frame {
    LAS unsigned char* lds; int wave, vcu, G, bx;
    float* out; unsigned char* ws; const float* x; const float* ctx;
};
__device__ __forceinline__ unsigned char* wl(const Frame& F, int  , size_t off) { return F.ws + WS_W + off; }
__device__ __forceinline__ float* fMOD(const Frame& F) { return (float*)(F.ws + WS_MOD); }
__device__ __forceinline__ bf16_t* fXN(const Frame& F) { return (bf16_t*)(F.ws + WS_XN); }
__device__ __forceinline__ unsigned char* fBIG(const Frame& F) { return F.ws + WS_BIG; }
__device__ __forceinline__ const float* fSM(const Frame& F, int off) { return (const float*)(F.ws + WS_SMALL) + off; }

__device__ __forceinline__ void tr_item(const float* __restrict__ W, int ldw, int k0, int srccol0, bool ropeperm, const float* __restrict__ gain, bool zero,
                                        bf16_t* __restrict__ WT, int ldt, int dstrow0, LAS float* scr, int lane) {
    if (!zero) {
        float v[32];
        const float* wp = W + (size_t)(k0 + (lane >> 5)) * ldw + srccol0 + (lane & 31);
#pragma unroll
        for (int i = 0; i < 32; ++i) v[i] = wp[(size_t)(2 * i) * ldw];
#pragma unroll
        for (int i = 0; i < 32; ++i) scr[(2 * i + (lane >> 5)) * 33 + (lane & 31)] = v[i];
    }
    LDS_WAIT(); asm volatile("" ::: "memory");
    const int c = lane & 7;
    float gk[8];
#pragma unroll
    for (int q = 0; q < 8; ++q) gk[q] = gain ? gain[k0 + 8 * c + q] : 1.0f;
#pragma unroll
    for (int j = 0; j < 4; ++j) { const int n = (lane >> 3) + 8 * j; const int sn = ropeperm ? (((n >> 2) & 1) * 16 + (n >> 3) * 4 + (n & 3)) : n;
        const LAS float* s = scr + (8 * c) * 33 + sn;
        u32x4 o;
        if (zero) { unsigned z_ = 0u; asm volatile("" : "+v"(z_)); o = (u32x4){z_, z_, z_, z_}; }
        else { o.x = cvt_pk_bf16(s[0 * 33] * gk[0], s[1 * 33] * gk[1]); o.y = cvt_pk_bf16(s[2 * 33] * gk[2], s[3 * 33] * gk[3]); o.z = cvt_pk_bf16(s[4 * 33] * gk[4], s[5 * 33] * gk[5]); o.w = cvt_pk_bf16(s[6 * 33] * gk[6], s[7 * 33] * gk[7]); }
        *(u32x4*)(WT + (size_t)(dstrow0 + n) * ldt + k0 + 8 * c) = o; }
    LDS_WAIT(); asm volatile("" ::: "memory");
}
__device__ __forceinline__ void convert_range(Frame& F, const float* const* in, const int l, const int it_lo, const int it_hi, const int gw, const int NGW);
__device__ __forceinline__ void p0_prologue(Frame& F, const float* const* in) {
    const int tid_ = opaque_tid(F.wave), lane_ = tid_ & 63; (void)tid_; (void)lane_;
    {
        LAS float* SC = (LAS float*)F.lds;
        for (int i = tid_; i < 17 * D; i += 512) { const int r = i >> 11, k = i & (D - 1); const float v = (r < 16) ? in[I_C][r * D + k] : in[I_CCTX][k]; SC[i] = silu_f(v); }
        __syncthreads();
        for (int item = F.bx; item < 256; item += F.G) {
            const int l = item >> 7, n0 = (item & 127) * 144;
            const float* W = in[I_ADAW] + (size_t)l * D * NMOD + n0 + 4 * lane_;
            f32x4 acc[17];
#pragma unroll
            for (int r = 0; r < 17; ++r) acc[r] = (f32x4){0.f, 0.f, 0.f, 0.f};
            const int kb = F.wave * 256;
            if (lane_ < 36) {
                for (int kk = 0; kk < 256; kk += 8) {
                    f32x4 w[8];
#pragma unroll
                    for (int q = 0; q < 8; ++q) w[q] = *(const f32x4*)(W + (size_t)(kb + kk + q) * NMOD);
#pragma unroll
                    for (int r = 0; r < 17; ++r) { const f32x4 s = *(const LAS f32x4*)(SC + r * D + kb + kk), s2 = *(const LAS f32x4*)(SC + r * D + kb + kk + 4);
                        acc[r] += w[0] * s[0]; acc[r] += w[1] * s[1]; acc[r] += w[2] * s[2]; acc[r] += w[3] * s[3];
                        acc[r] += w[4] * s2[0]; acc[r] += w[5] * s2[1]; acc[r] += w[6] * s2[2]; acc[r] += w[7] * s2[3]; }
                }
            }
            __syncthreads();
            LAS float* PT = (LAS float*)F.lds;
            LAS float* PT2 = (LAS float*)(F.lds + 0);
            (void)PT2;
            if (lane_ < 36) {
#pragma unroll
                for (int r = 0; r < 17; ++r) *(LAS f32x4*)(PT + (F.wave * 17 + r) * 144 + 4 * lane_) = acc[r];
            }
            __syncthreads();
            for (int i = tid_; i < 17 * 144; i += 512) { const int r = i / 144, cidx = i % 144; float s = in[I_ADAB][l * NMOD + n0 + cidx];
#pragma unroll
                for (int w = 0; w < 8; ++w) s += PT[(w * 17 + r) * 144 + cidx];
                fMOD(F)[((size_t)l * 17 + r) * NMOD + n0 + cidx] = s; }
            __syncthreads();
            if (item + F.G < 256) {
                for (int i = tid_; i < 17 * D; i += 512) { const int r = i >> 11, k = i & (D - 1); const float v = (r < 16) ? in[I_C][r * D + k] : in[I_CCTX][k]; SC[i] = silu_f(v); }
                __syncthreads();
            }
        }
    }
    if (F.bx == 0) {
        float* cosT = (float*)(F.ws + WS_ROPE); float* sinT = cosT + 1024;
        for (int i = tid_; i < 1024; i += 512) { const int pos = i >> 4, f = i & 15; const float inv = powf(10000.f, -(float)f / 16.f); const float ang = (float)pos * inv; cosT[i] = cosf(ang); sinT[i] = sinf(ang); }
    }
    { float* sm = (float*)(F.ws + WS_SMALL);
      for (int i = F.bx * 512 + tid_; i < SM_TOTAL; i += F.G * 512) { float v;
          if (i < SM_MIXN) v = in[I_F1N][i]; else if (i < SM_F2N) v = in[I_MIXN][i - SM_MIXN]; else if (i < SM_OUTN) v = in[I_F2N][i - SM_F2N]; else if (i < SM_FINN) v = in[I_OUTN][i - SM_OUTN];
          else if (i < SM_RPB) v = in[I_FINN][i - SM_FINN]; else v = in[I_RPB][i - SM_RPB];
          sm[i] = v; } }
    __syncthreads();
    convert_range(F, in, 0, 0, CV_ALL, F.vcu * 8 + F.wave, F.G * 8);
}
__device__ __forceinline__ void convert_range(Frame& F, const float* const* in, const int l, const int it_lo, const int it_hi, const int gw, const int NGW) {
    const int tid_ = opaque_tid(F.wave), lane_ = tid_ & 63; (void)tid_;
    __syncthreads();
    LAS float* scr = (LAS float*)(F.lds + F.wave * 16384);
    constexpr int I_13 = CV_I13, I_2 = CV_I2, I_IN = CV_IIN, I_UP = CV_IUP;
    for (int it = it_lo + gw; it < it_hi; it += NGW) {
        int r = it;
        bool done = false;
#pragma unroll
        for (int f = 0; f < 2; ++f) {
            if (!done && r < I_13) {
                const int nblk = 2 * DFF / 32, kb = r / nblk, nb = r % nblk, n0 = nb * 32, pn = n0 >> 8, j = n0 & 255;
                const float* W = (j < 128) ? in[f ? I_F2W1 : I_F1W1] : in[f ? I_F2W3 : I_F1W3];
                tr_item(W + (size_t)l * D * DFF, DFF, kb * 64, pn * 128 + (j & 127), false, nullptr, false, (bf16_t*)wl(F, l, f ? WL_W13B : WL_W13A), D, n0, scr, lane_); done = true; }
            if (!done) r -= I_13;
            if (!done && r < I_2) {
                const int nblk = D / 32, kb = r / nblk, nb = r % nblk;
                tr_item(in[f ? I_F2W2 : I_F1W2] + (size_t)l * DFF * D, D, kb * 64, nb * 32, false, nullptr, false, (bf16_t*)wl(F, l, f ? WL_W2B : WL_W2A), DFF, nb * 32, scr, lane_); done = true; }
            if (!done) r -= I_2;
        }
        if (done) continue;
        if (r < I_IN) {
            const int nblk = PINP / 32, kb = r / nblk, nb = r % nblk, n0 = nb * 32;
            const int src = (n0 < 1024) ? n0 : (n0 < 4096) ? n0 + 64 : (n0 < PIN) ? 1024 + (n0 - 4096) : 0;
            tr_item(in[I_WIN] + (size_t)l * D * PIN, PIN, kb * 64, src, n0 >= 4096 && n0 < PIN  , nullptr, n0 >= PIN, (bf16_t*)wl(F, l, WL_WIN), D, n0, scr, lane_); continue; }
        r -= I_IN;
        if (r < I_UP) {
            const int nblk = UPW / 32, kb = r / nblk, nb = r % nblk, n0 = nb * 32;
            if (n0 < QW) { const int within = n0 % 192;
                tr_item(in[I_WUQ] + (size_t)l * 512 * QW, QW, kb * 64, n0, within >= 128, in[I_QAN] + l * 512, false, (bf16_t*)wl(F, l, WL_WUP), 512, n0, scr, lane_); }
            else tr_item(in[I_WUKV] + (size_t)l * 512 * KVW, KVW, kb * 64, n0 - QW, false, in[I_KVAN] + l * 512, false, (bf16_t*)wl(F, l, WL_WUP), 512, n0, scr, lane_);
            continue; }
        r -= I_UP;
        { const int nblk = D / 32, kb = r / nblk, nb = r % nblk;
          tr_item(in[I_WOUT] + (size_t)l * D * D, D, kb * 64, nb * 32, false, in[I_OUTN] + l * D  , false, (bf16_t*)wl(F, l, WL_WOUT), D, nb * 32, scr, lane_); }
    }
}

__device__ __forceinline__ void cvec_layer(Frame& F, const int l);
__device__ __forceinline__ void init_phase(Frame& F) {
    const int tid_ = opaque_tid(F.wave), lane_ = tid_ & 63; (void)tid_;
    const int gw = F.vcu * 8 + F.wave, NGW = F.G * 8;
    {
        const float* gain = fSM(F, SM_F1N); float* SS = (float*)(F.ws + WS_SS);
        for (int it = gw; it < MT / 4; it += NGW) {
            const int row0 = it * 4; const int b = row0 < ML ? (row0 >> 11) : 16;
            const float* mod = fMOD(F) + (size_t)b * NMOD;
            f32x4 gs[4][2];
#pragma unroll
            for (int j = 0; j < 4; ++j)
#pragma unroll
                for (int h = 0; h < 2; ++h) { const int c = 8 * lane_ + 512 * j + 4 * h; gs[j][h] = *(const f32x4*)(gain + c) * (*(const f32x4*)(mod + 1 * D + c) + 1.0f); }
#pragma unroll 2
            for (int rr = 0; rr < 4; ++rr) { const int row = row0 + rr;
                const float* hp = (row < ML) ? F.x + (size_t)row * D : F.ctx + (size_t)(row - ML) * D;
                f32x4 v[4][2]; float ss = 0.f;
#pragma unroll
                for (int j = 0; j < 4; ++j)
#pragma unroll
                    for (int h = 0; h < 2; ++h) { v[j][h] = *(const f32x4*)(hp + 8 * lane_ + 512 * j + 4 * h); const f32x4 x = v[j][h]; ss += (x[0] * x[0] + x[1] * x[1]) + (x[2] * x[2] + x[3] * x[3]); }
                ss = wave_sum(ss, lane_);
                if (lane_ < 8) SS[(size_t)row * 8 + lane_] = (lane_ == 0) ? ss : 0.f;
                bf16_t* op = fXN(F) + (size_t)row * XNP + 8 * lane_;
                _Float16* hp16 = (_Float16*)(F.ws + WS_H16) + (size_t)row * D + 8 * lane_;
#pragma unroll
                for (int j = 0; j < 4; ++j) { u32x4 hv; hv.x = cvt_pk_f16(v[j][0][0], v[j][0][1]); hv.y = cvt_pk_f16(v[j][0][2], v[j][0][3]); hv.z = cvt_pk_f16(v[j][1][0], v[j][1][1]); hv.w = cvt_pk_f16(v[j][1][2], v[j][1][3]);
                    *(u32x4*)(hp16 + 512 * j) = hv; }
#pragma unroll
                for (int j = 0; j < 4; ++j) { const f32x4 a = v[j][0] * gs[j][0], c = v[j][1] * gs[j][1];
                    u32x4 w; w.x = cvt_pk_bf16(a[0], a[1]); w.y = cvt_pk_bf16(a[2], a[3]); w.z = cvt_pk_bf16(c[0], c[1]); w.w = cvt_pk_bf16(c[2], c[3]);
                    *(u32x4*)(op + 512 * j) = w; }
            }
        }
    }
    cvec_layer(F, 0);
}
__device__ __forceinline__ void cvec_layer(Frame& F, const int l) {
    const int tid_ = opaque_tid(F.wave), lane_ = tid_ & 63;
    const int gw = F.vcu * 8 + F.wave, NGW = F.G * 8;
    constexpr int PITCH = D + 8;
    LAS bf16_t* SHH = (LAS bf16_t*)F.lds; LAS bf16_t* SHL = SHH + 17 * PITCH;
    static_assert(2 * 17 * PITCH * 2 <= LDSCTL_OFF, "cvec_layer LDS");
    int sp, lw, nw;
    { const int w = (F.vcu * 256) / F.G;
      if (w < 108) { sp = 0; lw = w; nw = 108; } else if (w < 148) { sp = 1; lw = w - 108; nw = 40; } else { sp = 2; lw = w - 148; nw = 108; } }
    const bool fullgrid = (F.G == 256);
    for (int pass = 0; pass < (fullgrid ? 1 : 3); ++pass) {
        const int s = fullgrid ? sp : pass;
        const int N = (s == 1) ? PINP : 2 * DFF; const int sidx = 3 * s;
        const bf16_t* Wt = (const bf16_t*)wl(F, l, s == 0 ? WL_W13A : s == 1 ? WL_WIN : WL_W13B);
        float* out = (float*)(F.ws + WS_CB) + (size_t)l * CB_LAYER + (s == 0 ? CB_S0 : s == 1 ? CB_S1 : CB_S2);
        __syncthreads();
        for (int i = tid_; i < 17 * D; i += 512) { const int b = i >> 11, k = i & (D - 1); const float v = fMOD(F)[((size_t)l * 17 + b) * NMOD + sidx * D + k];
            const unsigned hb = f2bf(v); const float lo = v - bf2f(hb); SHH[b * PITCH + k] = (bf16_t)hb; SHL[b * PITCH + k] = (bf16_t)f2bf(lo); }
        __syncthreads();
        const int r32 = lane_ & 31, hi = lane_ >> 5, brow = r32 < 16 ? r32 : 16;
        const int gwl = fullgrid ? lw * 8 + F.wave : gw, ngwl = fullgrid ? nw * 8 : NGW;
        for (int blk = gwl; blk < N / 32; blk += ngwl) {
            const bf16_t* wp = Wt + (size_t)(blk * 32 + r32) * D + hi * 8;
            const LAS bf16_t* ah = SHH + brow * PITCH + hi * 8; const LAS bf16_t* al = SHL + brow * PITCH + hi * 8;
            f32x16 acc;
#pragma unroll
            for (int r = 0; r < 16; ++r) acc[r] = 0.f;
            for (int k0 = 0; k0 < D; k0 += 128) {
                bf16x8 bw[8];
#pragma unroll
                for (int q = 0; q < 8; ++q) bw[q] = *(const bf16x8*)(wp + k0 + 16 * q);
#pragma unroll
                for (int q = 0; q < 8; ++q) { const bf16x8 a0 = *(const LAS bf16x8*)(ah + k0 + 16 * q), a1 = *(const LAS bf16x8*)(al + k0 + 16 * q);
                    acc = __builtin_amdgcn_mfma_f32_32x32x16_bf16(a0, bw[q], acc, 0, 0, 0);
                    acc = __builtin_amdgcn_mfma_f32_32x32x16_bf16(a1, bw[q], acc, 0, 0, 0); }
            }
#pragma unroll
            for (int r = 0; r < 16; ++r) { const int b = (r & 3) + 8 * (r >> 2) + 4 * hi; if (b < 17) out[(size_t)b * N + blk * 32 + r32] = acc[r]; }
        }
    }
}
__device__ __forceinline__ void final_phase(Frame& F) {
    const int tid_ = opaque_tid(F.wave), lane_ = tid_ & 63; (void)tid_;
    const int gw = F.vcu * 8 + F.wave, NGW = F.G * 8;
    const float* gain = fSM(F, SM_FINN);
    f32x4 g[4][2];
#pragma unroll
    for (int j = 0; j < 4; ++j)
#pragma unroll
        for (int h = 0; h < 2; ++h) g[j][h] = *(const f32x4*)(gain + 8 * lane_ + 512 * j + 4 * h);
    for (int row = gw; row < ML; row += NGW) {
        const _Float16* hp = (const _Float16*)(F.ws + WS_H16) + (size_t)row * D + 8 * lane_;
        float* op = F.out + (size_t)row * D + 8 * lane_;
        f32x4 v[4][2]; float ss = 0.f;
#pragma unroll
        for (int j = 0; j < 4; ++j) { h8_to_f32(*(const u32x4*)(hp + 512 * j), v[j][0], v[j][1]);
#pragma unroll
            for (int h = 0; h < 2; ++h) { const f32x4 x = v[j][h]; ss += (x[0] * x[0] + x[1] * x[1]) + (x[2] * x[2] + x[3] * x[3]); } }
        const float rinv = 1.0f / sqrtf(wave_sum(ss, lane_) * (1.0f / D) + EPS);
#pragma unroll
        for (int j = 0; j < 4; ++j)
#pragma unroll
            for (int h = 0; h < 2; ++h) *(f32x4*)(op + 512 * j + 4 * h) = v[j][h] * rinv * g[j][h];
    }
}

__device__ __forceinline__ void attn_phase(Frame& F, int l, bool ctx_out) {
    const int grp = F.vcu >> 3, k8 = F.vcu & 7;
    const bf16_t* Q = (const bf16_t*)(fBIG(F) + BG_Q); const bf16_t* KV = (const bf16_t*)(fBIG(F) + BG_KV); const bf16_t* KR = (const bf16_t*)(fBIG(F) + BG_KR);
    const bf16_t* NQ = (const bf16_t*)(fBIG(F) + BG_NQKV); const bf16_t* NK = NQ + (size_t)MT * 1024; const bf16_t* NV = NK + (size_t)MT * 1024;
    bf16_t* AO = (bf16_t*)(F.ws + WS_AO); float* SSA = (float*)(fBIG(F) + BG_KRF);
#ifndef ATT_ONLY
#define ATT_ONLY 0
#endif
    const int nmla = (ATT_ONLY == 2) ? 0 : 4 + ((ctx_out && F.vcu < 128) ? 1 : 0);
    for (int i = 0; i < nmla; ++i) {
        int b, h, q0, base1, n1;
        if (i < 4) { const int bh = grp + 32 * i; b = bh >> 3; h = bh & 7; q0 = b * SEQ + k8 * 256; base1 = b * SEQ; n1 = 32; }
        else { const int bh = F.vcu; b = bh >> 3; h = bh & 7; q0 = ML + b * CTXL; base1 = 0; n1 = 0; }
        att::attn_unit<192, false>(F.lds, F.wave, Q + (size_t)q0 * QW + h * 192, QW, KV + h * 256, KV + h * 256 + 128, KVW, KR,
                                   base1, n1, ML + b * CTXL, 4, MLA_SCALE, AO + (size_t)q0 * D + h * 128, D, nullptr, 0, 0, SSA + (size_t)q0 * 16 + h);
    }
    const int nna = (ATT_ONLY == 1) ? 0 : 4 + ((ctx_out && F.vcu >= 128) ? 1 : 0);
    for (int i = 0; i < nna; ++i) {
        int b, h, q0, base1, n1, strip0, qgr0;
        if (i < 4) { const int bh = grp + 32 * i; b = bh >> 3; h = bh & 7; const int rg = (k8 + 2 * i) & 7; qgr0 = 4 * rg; q0 = b * SEQ + rg * 256;
            strip0 = min(max(qgr0 - 4, 0), 24); const int send = min(max(qgr0 + 3 - 4, 0), 24) + 8; n1 = send - strip0; base1 = b * SEQ + strip0 * 64; }
        else { const int bh = F.vcu - 128; b = bh >> 3; h = bh & 7; q0 = ML + b * CTXL; base1 = 0; n1 = 0; strip0 = 0; qgr0 = 0; }
        att::attn_unit<128, true>(F.lds, F.wave, NQ + (size_t)q0 * 1024 + h * 128, 1024, NK + h * 128, NV + h * 128, 1024, nullptr,
                                  base1, n1, ML + b * CTXL, 4, NA_SCALE, AO + (size_t)q0 * D + 1024 + h * 128, D, fSM(F, SM_RPB) + (l * 8 + h) * 465, strip0, qgr0, SSA + (size_t)q0 * 16 + 8 + h);
    }
}

__global__ void __launch_bounds__(512, 2) mk_fwd(Args args) {
    extern __shared__ __attribute__((aligned(16))) unsigned char lds_raw[];
    Frame F;
    F.lds = (LAS unsigned char*)lds_raw;
    const int wave0 = __builtin_amdgcn_readfirstlane((int)threadIdx.x >> 6), G0 = gridDim.x, bx0 = blockIdx.x;
    const int vcu0 = (G0 % 8 == 0) ? (bx0 % 8) * (G0 / 8) + bx0 / 8 : bx0;
    F.wave = wave0; F.G = G0; F.vcu = vcu0; F.bx = bx0;
    F.out = args.out; F.ws = args.ws; F.x = args.in[I_X]; F.ctx = args.in[I_CTX];
    volatile LAS unsigned* MISC = (volatile LAS unsigned*)(F.lds + MISC_OFF);
    for (int u = threadIdx.x; u < (LDS_BYTES - LDSCTL_OFF) / 4; u += 512) ((LAS unsigned*)(F.lds + LDSCTL_OFF))[u] = 0u;
    __syncthreads();
    unsigned* ctl = (unsigned*)(args.ws + WS_CTL);
    XcdBarrier bar; bar.bar = ctl + CW_BAR; bar.x = 0; bar.st = nullptr; bar.wave = 0;
    const int lo = args.ph_lo, hi = args.ph_hi;
    const bool use_bar = (hi - lo) > 1;
    if (use_bar) bar = xcd_barrier_post(ctl + CW_BAR, MISC + 8);
    bar.wave = wave0;
#ifndef MK_ONLY
#define MK_ONLY -1
#endif
#define TY(t) (MK_ONLY < 0 || MK_ONLY == (t))
#ifndef MK_REP_TYPE
#define MK_REP_TYPE -1
#endif
#ifndef MK_REP_N
#define MK_REP_N 1
#endif
#define NREP(t) ((MK_REP_TYPE == (t)) ? MK_REP_N : 1)
#define REPEAT(t) for (int rp_ = 0; rp_ < NREP(t); ++rp_)
#define REPBAR() do { if (rp_ > 0) xcd_barrier(bar); } while (0)
#ifndef MK_FUSEFIN
#define MK_FUSEFIN 1
#endif
#ifndef MK_SPK
#define MK_SPK 1
#endif
#ifndef MK_WGM_SWI
#define MK_WGM_SWI 4
#endif
#ifndef MK_WGM_DOWN
#define MK_WGM_DOWN 4
#endif
#ifndef MK_WGM_WIN
#define MK_WGM_WIN 4
#endif
#ifndef MK_WGM_UP
#define MK_WGM_UP 4
#endif
#ifndef MK_WGM_WOUT
#define MK_WGM_WOUT 4
#endif
#ifndef MK_REP_NULL
#define MK_REP_NULL 0
#endif
#define IN(k) (lo <= (k) && (k) < hi)
#define SEAM(k) do { if (IN(k) && IN((k) + 1)) xcd_barrier(bar); } while (0)
#define FRESH() do { unsigned char* w_ = args.ws; float* o_ = args.out; int wv_ = wave0, vc_ = vcu0, g_ = G0, bx_ = bx0; asm volatile("" : "+s"(w_), "+s"(o_), "+s"(wv_), "+s"(vc_), "+s"(g_), "+s"(bx_)); F.ws = w_; F.out = o_; F.wave = wv_; F.vcu = vc_; F.G = g_; F.bx = bx_; } while (0)
    LAS unsigned char* ring = F.lds;

    if (TY(0) && IN(0)) REPEAT(0) { REPBAR(); FRESH(); p0_prologue(F, args.in); } SEAM(0);
    if (TY(1) && IN(1)) REPEAT(1) { REPBAR(); FRESH(); init_phase(F); } SEAM(1);

#pragma unroll 1
    for (int l = 0; l < DEPTH; ++l) {
        const int pb = 2 + 9 * l; const bool last = (l == DEPTH - 1);
        const bool tailcv = (!last) && (F.G == 256);
        const bool fusefin = MK_FUSEFIN && (F.G == 256) && (MK_REP_TYPE < 0);
        if (l > 0) {
            if (TY(0) && IN(pb - 1)) { FRESH(); if (F.G == 256) { convert_range(F, args.in, l, CV_W2B, CV_WIN, F.vcu * 8 + F.wave, F.G * 8); convert_range(F, args.in, l, CV_WOUT, CV_ALL, F.vcu * 8 + F.wave, F.G * 8); }
                else convert_range(F, args.in, l, 0, CV_ALL, F.vcu * 8 + F.wave, F.G * 8);
                __syncthreads(); cvec_layer(F, l); }
            SEAM(pb - 1);
        }
#define TAILCV_AT(thr_, lo_, hi_) do { if (tailcv && F.bx >= (thr_)) convert_range(F, args.in, l + 1, (lo_), (hi_), (F.bx - (thr_)) * 8 + F.wave, (256 - (thr_)) * 8); } while (0)
#define TAILCV_IDLE(lo_, hi_) do { if (tailcv && F.bx >= 128) convert_range(F, args.in, l + 1, (lo_), (hi_), (F.bx - 128) * 8 + F.wave, 1024); } while (0)
#define TAILCV_SPLIT(lo_, hi_) do { if (tailcv) { const int off_ = F.bx >> 3, j_ = ((off_ >> 1) * 8 + (F.bx & 7)) * 8 + F.wave; \
        if (off_ & 1) { convert_range(F, args.in, l + 1, (lo_), (hi_), j_, 3072); convert_range(F, args.in, l + 1, (lo_), (hi_), 1024 + j_, 3072); } else convert_range(F, args.in, l + 1, (lo_), (hi_), 2048 + j_, 3072); } } while (0)
#define SPKSET(ph_) do { if (F.G == 256 && rp_ == 0) { S.spk = F.ws; S.epoch = (ph_) + 1; } } while (0)
#if MK_SPK & 1
#define TAILCV_D TAILCV_SPLIT
#else
#define TAILCV_D TAILCV_IDLE
#endif
#if MK_SPK & 2
#define TAILCV_O TAILCV_SPLIT
#else
#define TAILCV_O TAILCV_IDLE
#endif
#define MODL (fMOD(F) + (size_t)l * 17 * NMOD)
#define SSP ((float*)(F.ws + WS_SS))
#define CBP(s_) ((const float*)(F.ws + WS_CB) + (size_t)l * CB_LAYER + (s_))
        const int Mlate = last ? ML : MT;
        if (TY(2) && IN(pb + 0)) REPEAT(2) { REPBAR(); FRESH(); pg8::Gemm g{fXN(F), (const bf16_t*)wl(F, l, WL_W13A), XNP, D, D}; pg8::Order S; S.init(MT / 256, 2 * DFF / 256, F.G, F.bx, MK_WGM_SWI);
            pg8::EpiSwiGLU E{(bf16_t*)(fBIG(F) + BG_G), DFF, SSP, CBP(CB_S0)}; if (MK_REP_NULL && rp_) { pg8::EpiNull<true> EN; pg8::gemm_phase<pg8::EpiNull<true>, true, true>(ring, F.wave, g, S, EN); } else pg8::gemm_phase<pg8::EpiSwiGLU, true, true>(ring, F.wave, g, S, E); }
        SEAM(pb + 0);
        if (TY(3) && IN(pb + 1)) REPEAT(3) { REPBAR(); FRESH(); pg8::Gemm g{(const bf16_t*)(fBIG(F) + BG_G), (const bf16_t*)wl(F, l, WL_W2A), DFF, DFF, DFF}; pg8::Order S; S.init(MT / 256, D / 256, F.G, F.bx, MK_WGM_DOWN); if (MK_SPK & 1) SPKSET(pb + 1);
            pg8::EpiResid<false> E{F.ws, F.out, l, 2, rp_ ? 0.0f : 0.5f, 1, SM_MIXN + l * D, l, 4, 0};
            if (MK_REP_NULL && rp_) { pg8::EpiNull<true> EN; pg8::gemm_phase<pg8::EpiNull<true>, true, true>(ring, F.wave, g, S, EN); } else pg8::gemm_phase<pg8::EpiResid<false>, true, true, (MK_SPK & 1) != 0>(ring, F.wave, g, S, E);
            if (!(MK_SPK & 1)) TAILCV_IDLE(CV_W13A, CV_W2A); }
        SEAM(pb + 1);
        if (TY(4) && IN(pb + 2)) REPEAT(4) { REPBAR(); FRESH(); pg8::Gemm g{fXN(F), (const bf16_t*)wl(F, l, WL_WIN), XNP, D, D}; pg8::Order S; S.init(MT / 256, PINP / 256, F.G, F.bx, MK_WGM_WIN);
            pg8::EpiWin E{(bf16_t*)(fBIG(F) + BG_CQKV), (bf16_t*)(fBIG(F) + BG_NQKV), (bf16_t*)(fBIG(F) + BG_KR), (float*)(F.ws + WS_RINV), SSP, CBP(CB_S1), (const float*)(F.ws + WS_ROPE)}; pg8::gemm_phase<pg8::EpiWin, true, true>(ring, F.wave, g, S, E);
            if (MK_SPK & 1) TAILCV_AT(144, CV_W13A, CV_W2A); }
        SEAM(pb + 2);
        if (TY(6) && IN(pb + 3)) REPEAT(6) { REPBAR(); FRESH(); pg8::Gemm g{(const bf16_t*)(fBIG(F) + BG_CQKV), (const bf16_t*)wl(F, l, WL_WUP), 1024, 512, 512}; pg8::Order S; S.init(MT / 256, UPW / 256, F.G, F.bx, MK_WGM_UP, 6, 512);
            const float* cosT = (const float*)(F.ws + WS_ROPE);
            pg8::EpiUp E{(bf16_t*)(fBIG(F) + BG_Q), (bf16_t*)(fBIG(F) + BG_KV), (const float*)(F.ws + WS_RINV), cosT, cosT + 1024}; pg8::gemm_phase<pg8::EpiUp, true, true>(ring, F.wave, g, S, E); }
        SEAM(pb + 3);
        if (TY(7) && IN(pb + 4)) REPEAT(7) { REPBAR(); FRESH(); attn_phase(F, l, !last); }
        SEAM(pb + 4);
        if (TY(3) && IN(pb + 5)) REPEAT(10) { REPBAR(); FRESH(); pg8::Gemm g{(const bf16_t*)(F.ws + WS_AO), (const bf16_t*)wl(F, l, WL_WOUT), D, D, D}; pg8::Order S; S.init(Mlate / 256, D / 256, F.G, F.bx, MK_WGM_WOUT); if (MK_SPK & 2) SPKSET(pb + 5);
            pg8::EpiResid<true> E{F.ws, F.out, l, 5, rp_ ? 0.0f : 1.0f, 1, SM_F2N + l * D, l, 7, 0};
            if (MK_REP_NULL && rp_) { pg8::EpiNull<true> EN; pg8::gemm_phase<pg8::EpiNull<true>, true, true>(ring, F.wave, g, S, EN); } else pg8::gemm_phase<pg8::EpiResid<true>, true, true, (MK_SPK & 2) != 0>(ring, F.wave, g, S, E);
            TAILCV_O(CV_W2A, CV_W13B); TAILCV_O(CV_WUP, CV_WOUT); if (MK_SPK & 1) TAILCV_O(CV_WIN, CV_WUP); }
        SEAM(pb + 5);
        if (TY(2) && IN(pb + 6)) REPEAT(2) { REPBAR(); FRESH(); pg8::Gemm g{fXN(F), (const bf16_t*)wl(F, l, WL_W13B), XNP, D, D}; pg8::Order S; S.init(Mlate / 256, 2 * DFF / 256, F.G, F.bx, MK_WGM_SWI);
            pg8::EpiSwiGLU E{(bf16_t*)(fBIG(F) + BG_G), DFF, SSP, CBP(CB_S2)}; if (MK_REP_NULL && rp_) { pg8::EpiNull<true> EN; pg8::gemm_phase<pg8::EpiNull<true>, true, true>(ring, F.wave, g, S, EN); } else pg8::gemm_phase<pg8::EpiSwiGLU, true, true>(ring, F.wave, g, S, E); }
        SEAM(pb + 6);
        if (TY(3) && IN(pb + 7)) REPEAT(3) { REPBAR(); FRESH(); pg8::Gemm g{(const bf16_t*)(fBIG(F) + BG_G), (const bf16_t*)wl(F, l, WL_W2B), DFF, DFF, DFF}; pg8::Order S; S.init(Mlate / 256, D / 256, F.G, F.bx, MK_WGM_DOWN); if (MK_SPK & 1) SPKSET(pb + 7);
            const int ln = last ? l : l + 1;
            pg8::EpiResid<false> E{F.ws, F.out, l, 8, (rp_ && !last) ? 0.0f : 0.5f, last ? 0 : 1, SM_F1N + ln * D, ln, 1, (last && fusefin) ? 1 : 0};
            if (MK_REP_NULL && rp_) { pg8::EpiNull<true> EN; pg8::gemm_phase<pg8::EpiNull<true>, true, true>(ring, F.wave, g, S, EN); } else pg8::gemm_phase<pg8::EpiResid<false>, true, true, (MK_SPK & 1) != 0>(ring, F.wave, g, S, E);
            TAILCV_D(CV_W13B, CV_W2B); if (!(MK_SPK & 1)) TAILCV_D(CV_WIN, CV_WUP); }
        if (!(last && fusefin)) SEAM(pb + 7);
    }
    if (TY(9) && IN(NPHASE - 1) && !(MK_FUSEFIN && (F.G == 256) && (MK_REP_TYPE < 0))) { FRESH(); final_phase(F); }
#undef IN
#undef SEAM
}

#if MK_DEBUG
__device__ __forceinline__ double dbf(bf16_t b) { return (double)__builtin_bit_cast(float, ((unsigned)b) << 16); }
__device__ __forceinline__ unsigned hsh(unsigned x) { x ^= x >> 16; x *= 0x7feb352du; x ^= x >> 15; x *= 0x846ca68bu; x ^= x >> 16; return x; }
__device__ __forceinline__ double dsilu(double x) { return x / (1.0 + exp(-x)); }
__device__ __forceinline__ double dh16(const _Float16* p) { return (double)(float)*p; }
struct DbgLoc { const void* p; int isbf; float atol; };
__device__ void dbg_sample(const Args& a, int ph, int s, double& expv, DbgLoc& loc) {
    const unsigned char* ws = a.ws; const float* const* in = a.in;
    const float* MOD = (const float*)(ws + WS_MOD); const _Float16* H16 = (const _Float16*)(ws + WS_H16); const bf16_t* XN = (const bf16_t*)(ws + WS_XN); const unsigned char* BIG = ws + WS_BIG;
    const unsigned h1 = hsh(s * 2654435761u + ph * 97u + 1u), h2 = hsh(h1 + 0x9e3779b9u), h3 = hsh(h2 + 77u);
    loc.atol = 0.02f; loc.isbf = 1; loc.p = nullptr; expv = 0.0;
    if (ph == 0) { const int l = h1 & 1, r = h2 % 17, n = h3 % NMOD; double acc = in[I_ADAB][l * NMOD + n];
        for (int k = 0; k < D; ++k) { const double c = (r < 16) ? in[I_C][r * D + k] : in[I_CCTX][k]; acc += dsilu(c) * (double)in[I_ADAW][((size_t)l * D + k) * NMOD + n]; }
        expv = acc; loc.p = MOD + ((size_t)l * 17 + r) * NMOD + n; loc.isbf = 0; loc.atol = 0.002f; return; }
    if (ph == NPHASE - 1) { const int row = h1 % ML, col = h2 % D; const _Float16* hp = H16 + (size_t)row * D; double ss = 0; for (int k = 0; k < D; ++k) ss += dh16(hp + k) * dh16(hp + k);
        expv = dh16(hp + col) / sqrt(ss / D + 1e-6) * in[I_FINN][col]; loc.p = a.out + (size_t)row * D + col; loc.isbf = 0; loc.atol = 0.002f; return; }
    if (ph == 1 || ph == 10) {
        const int l = (ph == 1) ? 0 : 1, s = h2 % 3, b = h3 % 17; const int N = (s == 1) ? PINP : 2 * DFF; const int n = hsh(h3 + 5u) % N;
        const bf16_t* Wt = (const bf16_t*)(ws + WS_W + (s == 0 ? WL_W13A : s == 1 ? WL_WIN : WL_W13B)) + (size_t)n * D;
        double acc = 0; for (int k = 0; k < D; ++k) acc += (double)MOD[((size_t)l * 17 + b) * NMOD + 3 * s * D + k] * dbf(Wt[k]);
        expv = acc; loc.p = (const float*)(ws + WS_CB) + (size_t)l * CB_LAYER + (s == 0 ? CB_S0 : s == 1 ? CB_S1 : CB_S2) + (size_t)b * N + n; loc.isbf = 0; loc.atol = 0.002f; return; }
    const int l = (ph < 10) ? 0 : 1; int st = (ph < 10) ? ph - 2 : ph - 11; if (st >= 3) st += 1; if (st >= 6) st += 1;
    const bool last = (l == DEPTH - 1);
    const float* modl = MOD + (size_t)l * 17 * NMOD;
    const int Mlate = last ? ML : MT;
    const bf16_t* AO = (const bf16_t*)(ws + WS_AO);
    auto pickrow = [&](int M) -> int { const int q = s & 7; if (q == 0) return 0; if (q == 1) return M - 1; if (q == 2 && M > ML) return ML + (int)(h1 % MC); return (int)(h1 % (unsigned)M); };
    if (st == 0 || st == 8 || st == 2) {
        const int M = (st == 8) ? Mlate : MT; const int row = pickrow(M); const int b = row < ML ? row >> 11 : 16;
        const _Float16* hp = H16 + (size_t)row * D; const float* gain = in[st == 0 ? I_F1N : st == 2 ? I_MIXN : I_F2N] + l * D; const int si = st == 0 ? 0 : st == 2 ? 3 : 6;
        double ss = 0; for (int q = 0; q < D; ++q) ss += dh16(hp + q) * dh16(hp + q);
        const double rinv = 1.0 / sqrt(ss / D + 1e-6);
        if (st == 2) {
            const float* w = in[I_WIN] + (size_t)l * D * PIN;
            auto dotc = [&](int c) -> double { double x = 0; for (int k = 0; k < D; ++k) { const double xn = dh16(hp + k) * rinv * gain[k] * (1.0 + modl[(size_t)b * NMOD + (si + 1) * D + k]) + modl[(size_t)b * NMOD + si * D + k]; x += xn * w[(size_t)k * PIN + c]; } return x; };
            if ((s & 15) == 5) {
                const int pn = h2 & 3; double ss2 = 0; for (int c = 0; c < 256; ++c) { const double v = dotc(pn * 256 + c); ss2 += v * v; }
                expv = ss2; loc.p = (const float*)(ws + WS_RINV) + (size_t)row * 4 + pn; loc.isbf = 0; loc.atol = 0.5f; return; }
            const int c = h2 % PIN;
            if (c >= 1024 && c < 1088) { const int j = c - 1024, axis = j >> 5, half = (j >> 4) & 1, f = j & 15; const double xa = dotc(1024 + axis * 32 + f), xb = dotc(1024 + axis * 32 + 16 + f); double v;
                if (row < ML) { const int t = row & (SEQ - 1); const double pos = axis ? (t & 63) : (t >> 6); const double ang = pos * (double)powf(10000.f, -(float)f / 16.f); v = half ? xa * sin(ang) + xb * cos(ang) : xa * cos(ang) - xb * sin(ang); }
                else v = half ? xb : xa;
                expv = v; loc.p = (const bf16_t*)(BIG + BG_KR) + (size_t)row * 64 + axis * 32 + 8 * (f >> 2) + 4 * half + (f & 3); return; }
            expv = dotc(c);
            if (c < 1024) loc.p = (const bf16_t*)(BIG + BG_CQKV) + (size_t)row * 1024 + c;
            else { const int cc = c - 1088; loc.p = (const bf16_t*)(BIG + BG_NQKV) + (size_t)(cc >> 10) * MT * 1024 + (size_t)row * 1024 + (cc & 1023); }
            return; }
        const int j = h2 % DFF; const float* w1 = in[st == 0 ? I_F1W1 : I_F2W1] + (size_t)l * D * DFF; const float* w3 = in[st == 0 ? I_F1W3 : I_F2W3] + (size_t)l * D * DFF;
        double x = 0, y = 0;
        for (int k = 0; k < D; ++k) { const double xn = dh16(hp + k) * rinv * gain[k] * (1.0 + modl[(size_t)b * NMOD + (si + 1) * D + k]) + modl[(size_t)b * NMOD + si * D + k]; x += xn * w1[(size_t)k * DFF + j]; y += xn * w3[(size_t)k * DFF + j]; }
        expv = dsilu(x) * y; loc.p = (const bf16_t*)(BIG + BG_G) + (size_t)row * DFF + j; return; }
    if (st == 1 || st == 9) {
        const int M = (st == 9) ? Mlate : MT; const int row = pickrow(M), col = h2 % D; const int b = row < ML ? row >> 11 : 16; const float* w2 = in[st == 1 ? I_F1W2 : I_F2W2] + (size_t)l * DFF * D;
        const bf16_t* G = (const bf16_t*)(BIG + BG_G) + (size_t)row * DFF; double x = 0; for (int k = 0; k < DFF; ++k) x += dbf(G[k]) * w2[(size_t)k * D + col];
        expv = dh16(H16 + (size_t)row * D + col) + 0.5 * modl[(size_t)b * NMOD + (st == 1 ? 2 : 8) * D + col] * x;
        loc.p = H16 + (size_t)row * D + col; loc.isbf = 2; loc.atol = 0.004f; return; }
    if (st == 4) {
        const int row = pickrow(MT), idx = h2 % UPW; const bf16_t* cq = (const bf16_t*)(BIG + BG_CQKV) + (size_t)row * 1024; const float* sq4 = (const float*)(ws + WS_RINV) + (size_t)row * 4;
        const double rq_ = 1.0 / sqrt(((double)sq4[0] + sq4[1]) / 512 + 1e-6), rkv_ = 1.0 / sqrt(((double)sq4[2] + sq4[3]) / 512 + 1e-6);
        if (idx >= QW) { const int c = idx - QW; const float* w = in[I_WUKV] + (size_t)l * 512 * KVW; const float* gn = in[I_KVAN] + l * 512; double x = 0; for (int k = 0; k < 512; ++k) x += dbf(cq[512 + k]) * gn[k] * w[(size_t)k * KVW + c];
            expv = x * rkv_; loc.p = (const bf16_t*)(BIG + BG_KV) + (size_t)row * KVW + c; return; }
        const int h = idx / 192, d = idx % 192; const float* w = in[I_WUQ] + (size_t)l * 512 * QW; const float* gn = in[I_QAN] + l * 512;
        auto qv = [&](int dd) -> double { double x = 0; for (int k = 0; k < 512; ++k) x += dbf(cq[k]) * gn[k] * w[(size_t)k * QW + h * 192 + dd]; return x * rq_; };
        if (d < 128) { expv = qv(d); loc.p = (const bf16_t*)(BIG + BG_Q) + (size_t)row * QW + h * 192 + d; return; }
        const int j = d - 128, axis = j >> 5, half = (j >> 4) & 1, f = j & 15; const double xa = qv(128 + axis * 32 + f), xb = qv(128 + axis * 32 + 16 + f); double v;
        if (row < ML) { const int t = row & (SEQ - 1); const double pos = axis ? (t & 63) : (t >> 6); const double ang = pos * (double)powf(10000.f, -(float)f / 16.f); v = half ? xa * sin(ang) + xb * cos(ang) : xa * cos(ang) - xb * sin(ang); }
        else v = half ? xb : xa;
        expv = v; loc.p = (const bf16_t*)(BIG + BG_Q) + (size_t)row * QW + h * 192 + 128 + axis * 32 + 8 * (f >> 2) + 4 * half + (f & 3); return; }
    if (st == 7) {
        const int row = pickrow(Mlate), col = h2 % D; const int b = row < ML ? row >> 11 : 16; const float* w = in[I_WOUT] + (size_t)l * D * D; const bf16_t* ao = AO + (size_t)row * D;
        double sa = 0, sb = 0; for (int k = 0; k < 1024; ++k) { const double va = dbf(ao[k]), vb = dbf(ao[1024 + k]); sa += va * va; sb += vb * vb; }
        const double ra = 1.0 / sqrt(sa / 1024 + 1e-6), rb = 1.0 / sqrt(sb / 1024 + 1e-6); double x = 0;
        for (int k = 0; k < D; ++k) x += dbf(ao[k]) * (k < 1024 ? ra : rb) * in[I_OUTN][l * D + k] * w[(size_t)k * D + col];
        expv = dh16(H16 + (size_t)row * D + col) + (double)modl[(size_t)b * NMOD + 5 * D + col] * x; loc.p = H16 + (size_t)row * D + col; loc.isbf = 2; loc.atol = 0.004f; return; }
    (void)XN;
}
__global__ void dbg_attn(Args a, int ph, int mode) {
    __shared__ float sc[2560]; __shared__ float red[2];
    const int l = (ph < 10) ? 0 : 1; const bool last = (l == DEPTH - 1);
    const unsigned char* BIG = a.ws + WS_BIG; const bf16_t* XN = (const bf16_t*)(a.ws + WS_AO);
    unsigned* dw = (unsigned*)(a.ws + WS_CTL) + CW_DBG + ph * 4; float* EXPB = (float*)(a.ws + WS_DBG);
    const int s = blockIdx.x, d = threadIdx.x;
    const unsigned h1 = hsh(s * 2654435761u + 12345u), h2 = hsh(h1 + 99u);
    const bool wantctx = (!last) && ((s & 7) == 3);
    const int row = wantctx ? ML + (int)(h1 % MC) : ((s & 7) == 0 ? (int)((h1 % NBATCH) * SEQ) : (s & 7) == 1 ? (int)((h1 % NBATCH) * SEQ + SEQ - 1) : (int)(h1 % ML));
    const int grpB = (h2 >> 3) & 1, h = h2 & 7;
    const int b = row < ML ? row >> 11 : (row - ML) >> 8;
    const bf16_t* AOp = XN + (size_t)row * D + (grpB ? 1024 : 0) + h * 128 + d;
    if (mode == 1) { const float ev = EXPB[s * 128 + d]; const float av = __builtin_bit_cast(float, ((unsigned)*AOp) << 16); const float ratio = fabsf(av - ev) / (0.02f * fabsf(ev) + 0.003f);
        if (!(ratio <= 1.0f)) atomicAdd(dw, 1u); atomicMax(dw + 1, __float_as_uint(ratio == ratio ? ratio : 1e30f)); return; }
    const int nlat = row < ML ? (grpB ? 512 : 2048) : 0; const int nk = nlat + 256;
    const int t = row & (SEQ - 1), gr = t >> 6, qc = t & 63, rs = min(max(gr - 4, 0), 24), cs0 = min(max(qc - 8, 0), 48);
    const bf16_t* Q = (const bf16_t*)(BIG + BG_Q); const bf16_t* KV = (const bf16_t*)(BIG + BG_KV); const bf16_t* KR = (const bf16_t*)(BIG + BG_KR);
    const bf16_t* NQ = (const bf16_t*)(BIG + BG_NQKV); const bf16_t* NK = NQ + (size_t)MT * 1024; const bf16_t* NV = NK + (size_t)MT * 1024;
    for (int k = d; k < nk; k += 128) {
        int krow; bool valid = true; double bias = 0;
        if (k < nlat) { if (grpB) { const int kr = rs + (k >> 6), kc = k & 63; krow = b * SEQ + kr * 64 + kc; valid = (kc >= cs0) && (kc < cs0 + 16); if (valid) bias = a.in[I_RPB][((size_t)(l * 8 + h) * 15 + (kr - gr + 7)) * 31 + (kc - qc + 15)]; } else krow = b * SEQ + k; }
        else krow = ML + b * CTXL + (k - nlat);
        double x = 0;
        if (!grpB) { for (int q = 0; q < 128; ++q) x += dbf(Q[(size_t)row * QW + h * 192 + q]) * dbf(KV[(size_t)krow * KVW + h * 256 + q]); for (int q = 0; q < 64; ++q) x += dbf(Q[(size_t)row * QW + h * 192 + 128 + q]) * dbf(KR[(size_t)krow * 64 + q]); x *= (double)MLA_SCALE; }
        else { for (int q = 0; q < 128; ++q) x += dbf(NQ[(size_t)row * 1024 + h * 128 + q]) * dbf(NK[(size_t)krow * 1024 + h * 128 + q]); x = x * (double)NA_SCALE + bias; }
        sc[k] = valid ? (float)x : -1e30f;
    }
    __syncthreads();
    float mx = -1e30f; for (int k = 0; k < nk; ++k) mx = fmaxf(mx, sc[k]);
    double den = 0, acc = 0;
    for (int k = 0; k < nk; ++k) { const double p = exp((double)sc[k] - (double)mx); if (sc[k] < -1e29f) continue; den += p;
        int krow; if (k < nlat) krow = grpB ? b * SEQ + (rs + (k >> 6)) * 64 + (k & 63) : b * SEQ + k; else krow = ML + b * CTXL + (k - nlat);
        acc += p * (grpB ? dbf(NV[(size_t)krow * 1024 + h * 128 + d]) : dbf(KV[(size_t)krow * KVW + h * 256 + 128 + d])); }
    EXPB[s * 128 + d] = (float)(acc / den);
    (void)red;
}
__global__ void dbg_check(Args a, int ph, int mode) {
    const int s = blockIdx.x * blockDim.x + threadIdx.x;
    unsigned* dw = (unsigned*)(a.ws + WS_CTL) + CW_DBG + ph * 4; float* EXPB = (float*)(a.ws + WS_DBG);
    double ev; DbgLoc loc; dbg_sample(a, ph, s, ev, loc);
    if (!loc.p) return;
    if (mode == 0) { EXPB[s] = (float)ev; return; }
    const float e = EXPB[s]; const float av = loc.isbf == 1 ? __builtin_bit_cast(float, ((unsigned)*(const bf16_t*)loc.p) << 16) : loc.isbf == 2 ? (float)*(const _Float16*)loc.p : *(const float*)loc.p;
    const float ratio = fabsf(av - e) / (0.02f * fabsf(e) + loc.atol);
    if (!(ratio <= 1.0f)) atomicAdd(dw, 1u);
    atomicMax(dw + 1, __float_as_uint(ratio == ratio ? ratio : 1e30f));
}
__global__ void dbg_report(Args a) {
    const unsigned* dw = (const unsigned*)(a.ws + WS_CTL) + CW_DBG; int bad = -1; float ratio = 0;
    for (int p = 0; p < NPHASE; ++p) if (dw[p * 4] != 0u) { bad = p; ratio = __uint_as_float(dw[p * 4 + 1]); break; }
    if (bad < 0) return;
    float e = 10.f * log10f(fmaxf(ratio, 1e-3f)) + 10.f; e = fminf(fmaxf(rintf(e), 1.f), 99.f);
    const float v = 1e4f * sqrtf(e);
    for (size_t i = (size_t)blockIdx.x * blockDim.x + threadIdx.x; i < (size_t)ML * D; i += (size_t)gridDim.x * blockDim.x) a.out[i] = (i == 0) ? 1e6f * (float)(bad + 1) : v;
}
#endif

extern "C" void kernel_launch(void* const* d_in, const int* in_sizes, int n_in, void* d_out, int out_size, void* d_ws, size_t ws_size, hipStream_t stream) {
    static int grid = 0;
    if (grid == 0) {
        if (n_in != 24 || in_sizes[0] != ML * D || out_size != ML * D || ws_size < WS_END) { fprintf(stderr, "kernel_launch: built for 24 inputs, x/out of %d floats, >= %zu bytes of workspace; got n_in %d, in0 %d, out %d, ws %zu; nothing launched\n", ML * D, (size_t)WS_END, n_in, n_in > 0 ? in_sizes[0] : -1, out_size, ws_size); grid = -1; return; }
        int dev = 0, cus = 0, per_cu = 0;
        if (hipGetDevice(&dev) != hipSuccess || hipDeviceGetAttribute(&cus, hipDeviceAttributeMultiprocessorCount, dev) != hipSuccess) { fprintf(stderr, "kernel_launch: device query failed\n"); grid = -1; return; }
        if (hipFuncSetAttribute((const void*)mk_fwd, hipFuncAttributeMaxDynamicSharedMemorySize, LDS_BYTES) != hipSuccess) { fprintf(stderr, "kernel_launch: hipFuncSetAttribute failed\n"); grid = -1; return; }
        if (hipOccupancyMaxActiveBlocksPerMultiprocessor(&per_cu, (const void*)mk_fwd, 512, LDS_BYTES) != hipSuccess || per_cu < 1) fprintf(stderr, "kernel_launch: note: occupancy query reports %d workgroups per CU\n", per_cu);
        (void)hipGetLastError();
        grid = cus;
    }
    if (grid < 0) return;
    if (hipMemsetAsync((char*)d_ws + WS_CTL, 0, CTL_ZERO_BYTES, stream) != hipSuccess) { fprintf(stderr, "kernel_launch: memset failed\n"); return; }
    Args a{};
    for (int i = 0; i < 24; ++i) a.in[i] = (const float*)d_in[i];
    a.out = (float*)d_out; a.ws = (unsigned char*)d_ws;
#if MK_PER_PHASE || MK_DEBUG
    for (int ph = 0; ph < NPHASE; ++ph) {
#if MK_DEBUG
        const bool isattn = (ph == 6 || ph == 15);
        if (isattn) hipLaunchKernelGGL(dbg_attn, dim3(64), dim3(128), 0, stream, a, ph, 0); else hipLaunchKernelGGL(dbg_check, dim3(16), dim3(64), 0, stream, a, ph, 0);
#endif
        a.ph_lo = ph; a.ph_hi = ph + 1;
        hipLaunchKernelGGL(mk_fwd, dim3(grid), dim3(512), LDS_BYTES, stream, a);
#if MK_DEBUG
        if (isattn) hipLaunchKernelGGL(dbg_attn, dim3(64), dim3(128), 0, stream, a, ph, 1); else hipLaunchKernelGGL(dbg_check, dim3(16), dim3(64), 0, stream, a, ph, 1);
#endif
    }
#if MK_DEBUG
    hipLaunchKernelGGL(dbg_report, dim3(1024), dim3(256), 0, stream, a);
#endif
#else
    a.ph_lo = 0; a.ph_hi = NPHASE;
    hipLaunchKernelGGL(mk_fwd, dim3(grid), dim3(512), LDS_BYTES, stream, a);
#endif
    const hipError_t le = hipPeekAtLastError();
    if (le != hipSuccess) fprintf(stderr, "kernel_launch: launch failed: %s\n", hipGetErrorName(le));
}
```

```cpp
#include <hip/hip_runtime.h>
#include <cstdio>
#include <cstdint>

#ifndef MK_PER_PHASE
#define MK_PER_PHASE 0
#endif
#ifndef MK_DEBUG
#define MK_DEBUG 0
#endif

#define LAS __attribute__((address_space(3)))
#define GAS __attribute__((address_space(1)))
typedef unsigned short bf16_t;
typedef short bf16x8 __attribute__((ext_vector_type(8)));
typedef short s16x4 __attribute__((ext_vector_type(4)));
typedef float f32x2 __attribute__((ext_vector_type(2)));
typedef float f32x4 __attribute__((ext_vector_type(4)));
typedef float f32x16 __attribute__((ext_vector_type(16)));
typedef unsigned u32x2 __attribute__((ext_vector_type(2)));
typedef unsigned u32x4 __attribute__((ext_vector_type(4)));
typedef _Float16 f16x8 __attribute__((ext_vector_type(8)));

constexpr int D = 2048, NBATCH = 16, SEQ = 2048, CTXL = 256, DFF = 5632, DEPTH = 2;
constexpr int ML = NBATCH * SEQ, MC = NBATCH * CTXL, MT = ML + MC;
constexpr int NMOD = 9 * D;
constexpr int PIN = 4160, PINP = 4352;
constexpr int QW = 1536, KVW = 2048, UPW = QW + KVW;
constexpr float EPS = 1e-6f;
constexpr float MLA_SCALE = 0.07216878364870322f;
constexpr float NA_SCALE = 0.08838834764831845f;
constexpr int CV_I13 = (D / 64) * (2 * DFF / 32), CV_I2 = (DFF / 64) * (D / 32), CV_IIN = (D / 64) * (PINP / 32), CV_IUP = (512 / 64) * (UPW / 32), CV_IOUT = (D / 64) * (D / 32);
constexpr int CV_W13A = 0, CV_W2A = CV_I13, CV_W13B = CV_W2A + CV_I2, CV_W2B = CV_W13B + CV_I13, CV_WIN = CV_W2B + CV_I2, CV_WUP = CV_WIN + CV_IIN, CV_WOUT = CV_WUP + CV_IUP, CV_ALL = CV_WOUT + CV_IOUT;
constexpr int NPHASE = 20;

constexpr size_t MiB = 1u << 20;
constexpr size_t WS_CTL = 0, CTL_ZERO_BYTES = 1 * MiB;
constexpr size_t WS_MOD = 1 * MiB;
constexpr size_t WS_ROPE = 4 * MiB;
constexpr size_t WS_SMALL = WS_ROPE + 65536;
constexpr int SM_F1N = 0, SM_MIXN = 2 * D, SM_F2N = 4 * D, SM_OUTN = 6 * D, SM_FINN = 8 * D, SM_RPB = 9 * D, SM_TOTAL = 9 * D + 2 * 8 * 465;
constexpr size_t WS_RINV = 5 * MiB;
constexpr size_t WS_H16 = 6 * MiB;
constexpr size_t WS_W = 150 * MiB;
constexpr size_t WL_W13A = 0, WL_W2A = 44 * MiB, WL_W13B = 66 * MiB, WL_W2B = 110 * MiB, WL_WIN = 132 * MiB, WL_WUP = 149 * MiB, WL_WOUT = 153 * MiB, WL_SIZE = 161 * MiB;
constexpr size_t WS_XN = WS_W + WL_SIZE;
constexpr int XNP = D + 64;
constexpr size_t WS_BIG = WS_XN + 149 * MiB;
constexpr size_t BG_G = 0;
constexpr size_t BG_CQKV = 0, BG_NQKV = 72 * MiB, BG_KRF = 288 * MiB, BG_KR = 297 * MiB, BG_Q = 302 * MiB, BG_KV = 410 * MiB;
constexpr size_t WS_DBG = WS_BIG + 554 * MiB;
constexpr size_t WS_AO = WS_DBG + 1 * MiB;
constexpr size_t WS_SS = WS_AO + 144 * MiB;
constexpr size_t WS_CB = WS_SS + 2 * MiB;
constexpr int CB_S0 = 0, CB_S1 = 17 * 2 * DFF, CB_S2 = CB_S1 + 17 * PINP, CB_LAYER = CB_S2 + 17 * 2 * DFF;
constexpr size_t WS_END = WS_CB + 4 * MiB;
constexpr int CW_FIN = 135168;
constexpr int CW_SPK = 131072;
constexpr int CW_BAR = 4096;
constexpr int CW_DBG = 65536;

constexpr int RING_BYTES = 131072;
constexpr int SSL_OFF = RING_BYTES;
constexpr int LDSCTL_OFF = 143360, MISC_OFF = LDSCTL_OFF + 64;
constexpr int LDS_BYTES = 147456;

__device__ __forceinline__ unsigned cvt_pk_bf16(float lo, float hi) { unsigned r; asm volatile("v_cvt_pk_bf16_f32 %0, %1, %2" : "=v"(r) : "v"(lo), "v"(hi)); return r; }
__device__ __forceinline__ unsigned f2bf(float f) { unsigned u = __builtin_bit_cast(unsigned, f); return (u + 0x7fffu + ((u >> 16) & 1u)) >> 16; }
__device__ __forceinline__ float bf2f(unsigned b) { return __builtin_bit_cast(float, b << 16); }
typedef _Float16 f16x2 __attribute__((ext_vector_type(2)));
__device__ __forceinline__ unsigned cvt_pk_f16(float lo, float hi) { unsigned r; asm volatile("v_cvt_pk_f16_f32 %0, %1, %2" : "=v"(r) : "v"(lo), "v"(hi)); return r; }
typedef float f32x8 __attribute__((ext_vector_type(8)));
__device__ __forceinline__ void h8_to_f32(const u32x4 v, f32x4& lo, f32x4& hi) {
    const f32x8 f = __builtin_convertvector(__builtin_bit_cast(f16x8, v), f32x8);
    lo = (f32x4){f[0], f[1], f[2], f[3]}; hi = (f32x4){f[4], f[5], f[6], f[7]}; }
__device__ __forceinline__ int lane_now() { unsigned z = 0u; asm volatile("" : "+v"(z)); return (int)__builtin_amdgcn_mbcnt_hi(~0u, __builtin_amdgcn_mbcnt_lo(~0u, z)); }
__device__ __forceinline__ int opaque_tid(int wave) { return wave * 64 + lane_now(); }
__device__ __forceinline__ float shfl_xor_f(float v, int o, int lane) { return __builtin_bit_cast(float, __builtin_amdgcn_ds_bpermute((lane ^ o) << 2, __builtin_bit_cast(int, v))); }
__device__ __forceinline__ float wave_sum(float v, int lane) {
#pragma unroll
    for (int o = 1; o < 64; o <<= 1) v += shfl_xor_f(v, o, lane);
    return v;
}
__device__ __forceinline__ float silu_f(float x) { return x * __builtin_amdgcn_rcpf(1.0f + __builtin_amdgcn_exp2f(-1.4426950408889634f * x)); }
#define LDS_WAIT() asm volatile("s_waitcnt lgkmcnt(0)" ::: "memory")
#define VM_WAIT() asm volatile("s_waitcnt vmcnt(0)" ::: "memory")

#ifndef MK_SPK_SKEW
#define MK_SPK_SKEW 6
#endif
namespace pg8 {
constexpr int BM = 256, BK = 64, HALF = 128, HTB = HALF * BK * 2, STAGE_BYTES = 8 * HTB, NXCD = 8;
__host__ __device__ __forceinline__ int lds_byte(int r, int c) { const int st = (r >> 4) * 2 + (c >> 5), rr = r & 15, cc = c & 31, ob = rr * 64 + cc * 2; return st * 1024 + (ob ^ (((ob >> 9) & 1) << 5)); }
__host__ __device__ __forceinline__ void stage_rc(int b, int& R, int& C) { const int st = b / 1024, sb = b % 1024, swz = sb ^ (((sb >> 9) & 1) << 5); R = (st >> 1) * 16 + swz / 64; C = (st & 1) * 32 + (swz % 64) / 2; }
__host__ __device__ __forceinline__ int perm32(int rho) { const int n = rho >> 4, i = rho & 15; return 8 * (i >> 2) + 4 * n + (i & 3); }

struct Unit { int pm, pn, acol, tail; };
struct Gemm { const bf16_t* A; const bf16_t* Bt; int lda, ldb, K; };
struct Order {
    unsigned char* spk; int epoch;
    int nM, nN, nwg, G, c, split_pn, split_acol, WGM;
    __device__ void init(int nM_, int nN_, int G_, int c_, int wgm_, int split_pn_ = 1 << 30, int split_acol_ = 0) { nM = nM_; nN = nN_; nwg = nM * nN; G = G_; c = c_; WGM = wgm_; split_pn = split_pn_; split_acol = split_acol_; spk = nullptr; epoch = 0; }
    __device__ bool next(int i, Unit& u) const {
        long L = (long)i * G + c; u.tail = 0;
        if (epoch != 0 && i == nwg / G && (nwg % G) * 2 == G) {
            const int xcd = c % NXCD, off = c / NXCD, tl = (off >> 1) * NXCD + xcd;
            L = (long)i * G + tl; u.tail = (off & 1) ? -(tl + 1) : (tl + 1);
        } else if (L >= nwg) return false;
        int wgid = (int)L; { const int q = nwg / NXCD, r = nwg % NXCD, xcd = wgid % NXCD, off = wgid / NXCD; wgid = (xcd < r ? xcd * (q + 1) : r * (q + 1) + (xcd - r) * q) + off; }
        const int nig = WGM * nN, gid = wgid / nig, fm = gid * WGM, gsz = (nM - fm) < WGM ? (nM - fm) : WGM;
        u.pm = fm + ((wgid % nig) % gsz); u.pn = (wgid % nig) / gsz; u.acol = (u.pn >= split_pn) ? split_acol : 0; return true;
    }
};

template <class Epi, bool ALIGN_EPI, bool SP2, bool SPK = false>
__device__ __forceinline__ void gemm_phase(LAS unsigned char* lds, const int wave, const Gemm g, const Order& S, const Epi& E) {
    const int tid = opaque_tid(wave), wid = __builtin_amdgcn_readfirstlane(tid >> 6), lane = tid & 63, wr = wid >> 2, wc = wid & 3, fr = lane & 15, fq = lane >> 4;
    const int K = g.K, nt = K / BK;
    unsigned voffA[2], voffB[2];
#pragma unroll
    for (int i = 0; i < 2; ++i) { int R, C; stage_rc(tid * 16 + i * 8192, R, C); const int Rb = Epi::PERM ? ((R & ~31) + perm32(R & 31)) : R;
        voffA[i] = (unsigned)(R * g.lda + C) * 2u; voffB[i] = (unsigned)(Rb * g.ldb + C) * 2u; }
    const size_t kstep = (size_t)(BK * 2);
    const size_t hstepA = (size_t)HALF * g.lda * 2, hstepB = (size_t)HALF * g.ldb * 2;
    const size_t tstepA = 2 * hstepA, tstepB = 2 * hstepB;
    const unsigned ldsw = (unsigned)wid * 1024u;
    const int aoff = lds_byte(wr * 64 + fr, fq * 8), boff = lds_byte(wc * 32 + fr, fq * 8);
#define PG8_SA(b, h) (((b) * 2 + (h)) * HTB)
#define PG8_SB(b, h) ((4 + (b) * 2 + (h)) * HTB)
#define PG8_STAGE(bufoff, gbase, voff) do { _Pragma("unroll") for (int _i = 0; _i < 2; ++_i) \
        __builtin_amdgcn_global_load_lds((const unsigned*)((const char*)(gbase) + (voff)[_i]), (LAS unsigned*)(lds + (bufoff) + ldsw + _i * 8192), 16, 0, 0); } while (0)
#define PG8_LDA(dst, b, h) do { _Pragma("unroll") for (int m = 0; m < 4; ++m) _Pragma("unroll") for (int k = 0; k < 2; ++k) dst[m][k] = *(const LAS bf16x8*)(lds + PG8_SA(b, h) + aoff + m * 2048 + k * 1024); } while (0)
#define PG8_LDB(dst, b, h) do { _Pragma("unroll") for (int n = 0; n < 2; ++n) _Pragma("unroll") for (int k = 0; k < 2; ++k) dst[n][k] = *(const LAS bf16x8*)(lds + PG8_SB(b, h) + boff + n * 2048 + k * 1024); } while (0)
#define PG8_MMA(ai, bj, At, Bt) do { __builtin_amdgcn_s_setprio(1); _Pragma("unroll") for (int m = 0; m < 4; ++m) _Pragma("unroll") for (int n = 0; n < 2; ++n) _Pragma("unroll") for (int k = 0; k < 2; ++k) \
        acc[ai][bj][m][n] = __builtin_amdgcn_mfma_f32_16x16x32_bf16(Bt[n][k], At[m][k], acc[ai][bj][m][n], 0, 0, 0); __builtin_amdgcn_s_setprio(0); } while (0)
#define PG8_WAIT_V(n) asm volatile("s_waitcnt vmcnt(" #n ")" ::: "memory")
#define PG8_WAIT_L(n) asm volatile("s_waitcnt lgkmcnt(" #n ")" ::: "memory")
#define PG8_BAR __builtin_amdgcn_s_barrier()
#define PG8_SCHED __builtin_amdgcn_sched_barrier(0)
    Unit cur, nxt; int ui = 0;
    if (!S.next(0, cur)) return;
    f32x4 acc[2][2][4][2];
#pragma unroll
    for (int a = 0; a < 2; ++a)
#pragma unroll
        for (int b = 0; b < 2; ++b)
#pragma unroll
            for (int m = 0; m < 4; ++m)
#pragma unroll
                for (int n = 0; n < 2; ++n) acc[a][b][m][n] = (f32x4){0.f, 0.f, 0.f, 0.f};
    bf16x8 At[4][2], B0[2][2], B1[2][2];
    const int ntb = ((nt >> 1) - (SPK ? MK_SPK_SKEW : 0)) & ~1;
#define PG8_KOFS(u) ((SPK && (u).tail > 0) ? (size_t)ntb * kstep : (size_t)0)
    const char* cA = (const char*)g.A + (size_t)cur.pm * tstepA + (size_t)cur.acol * 2 + PG8_KOFS(cur); const char* cB = (const char*)g.Bt + (size_t)cur.pn * tstepB + PG8_KOFS(cur);
    E.panel_setup(cur, -1, tid);
    typename Epi::Pre pre = E.pre_load(cur, tid);
    int prev_pm = -1;
    if constexpr (SP2) {
        PG8_STAGE(PG8_SB(0, 0), cB, voffB); PG8_STAGE(PG8_SB(0, 1), cB + hstepB, voffB); PG8_STAGE(PG8_SA(0, 0), cA, voffA); PG8_STAGE(PG8_SA(0, 1), cA + hstepA, voffA);
        if (wr == 1) PG8_BAR;
        PG8_WAIT_V(2); PG8_BAR;
        PG8_STAGE(PG8_SB(1, 0), cB + kstep, voffB); PG8_STAGE(PG8_SA(1, 0), cA + kstep, voffA); PG8_STAGE(PG8_SB(1, 1), cB + hstepB + kstep, voffB);
        PG8_WAIT_V(6); PG8_BAR;
    } else {
        PG8_STAGE(PG8_SB(0, 0), cB, voffB); PG8_STAGE(PG8_SA(0, 0), cA, voffA); PG8_STAGE(PG8_SB(0, 1), cB + hstepB, voffB); PG8_STAGE(PG8_SA(0, 1), cA + hstepA, voffA);
        if (wr == 1) PG8_BAR;
        PG8_WAIT_V(4); PG8_BAR;
        PG8_STAGE(PG8_SB(1, 0), cB + kstep, voffB); PG8_STAGE(PG8_SA(1, 0), cA + kstep, voffA); PG8_STAGE(PG8_SB(1, 1), cB + hstepB + kstep, voffB);
        PG8_WAIT_V(6); PG8_BAR;
    }
    for (;;) {
        const bool has_next = S.next(ui + 1, nxt);
        const char* nA = has_next ? (const char*)g.A + (size_t)nxt.pm * tstepA + (size_t)nxt.acol * 2 + PG8_KOFS(nxt) : cA; const char* nB = has_next ? (const char*)g.Bt + (size_t)nxt.pn * tstepB + PG8_KOFS(nxt) : cB;
        const int ntu = (SPK && cur.tail != 0) ? (cur.tail > 0 ? nt - ntb : ntb) : nt;
        for (int t = 0; t < ntu; t += 2) {
            const bool last = (t == ntu - 2);
            const char* a1 = cA + (size_t)(t + 1) * kstep;
            const char* a2 = last ? nA : cA + (size_t)(t + 2) * kstep; const char* b2 = last ? nB : cB + (size_t)(t + 2) * kstep;
            const char* a3 = a2 + kstep; const char* b3 = b2 + kstep;
            if constexpr (Epi::MIDSCALE) { if (t == nt / 2) E.mid(acc, wr, fr); }
            if constexpr (SP2) {
            PG8_LDB(B0, 0, 0); PG8_LDB(B1, 0, 1); PG8_SCHED; PG8_LDA(At, 0, 0); PG8_STAGE(PG8_SA(1, 1), a1 + hstepA, voffA);
            PG8_WAIT_V(8); PG8_WAIT_L(0); PG8_BAR; PG8_MMA(0, 0, At, B0); PG8_MMA(0, 1, At, B1); PG8_BAR; PG8_SCHED;
            PG8_LDA(At, 0, 1); PG8_STAGE(PG8_SB(0, 0), b2, voffB); PG8_STAGE(PG8_SB(0, 1), b2 + hstepB, voffB); PG8_STAGE(PG8_SA(0, 0), a2, voffA);
            PG8_WAIT_V(8); PG8_WAIT_L(0); PG8_BAR; PG8_MMA(1, 0, At, B0); PG8_MMA(1, 1, At, B1); PG8_BAR; PG8_SCHED;
            PG8_LDB(B0, 1, 0); PG8_LDB(B1, 1, 1); PG8_SCHED; PG8_LDA(At, 1, 0); PG8_STAGE(PG8_SA(0, 1), a2 + hstepA, voffA);
            PG8_WAIT_V(8); PG8_WAIT_L(0); PG8_BAR; PG8_MMA(0, 0, At, B0); PG8_MMA(0, 1, At, B1); PG8_BAR; PG8_SCHED;
            PG8_LDA(At, 1, 1); PG8_STAGE(PG8_SB(1, 0), b3, voffB); PG8_STAGE(PG8_SB(1, 1), b3 + hstepB, voffB); PG8_STAGE(PG8_SA(1, 0), a3, voffA);
            PG8_WAIT_V(8); PG8_WAIT_L(0); PG8_BAR; PG8_MMA(1, 0, At, B0); PG8_MMA(1, 1, At, B1); PG8_BAR; PG8_SCHED;
            } else {
            PG8_LDB(B0, 0, 0); PG8_SCHED; PG8_LDA(At, 0, 0); PG8_STAGE(PG8_SA(1, 1), a1 + hstepA, voffA);
            PG8_WAIT_L(8); PG8_BAR; PG8_WAIT_L(0); PG8_MMA(0, 0, At, B0); PG8_BAR; PG8_SCHED;
            PG8_LDB(B1, 0, 1); PG8_STAGE(PG8_SB(0, 0), b2, voffB);
            PG8_BAR; PG8_WAIT_L(0); PG8_MMA(0, 1, At, B1); PG8_BAR;
            PG8_LDA(At, 0, 1); PG8_STAGE(PG8_SA(0, 0), a2, voffA);
            PG8_BAR; PG8_WAIT_L(0); PG8_MMA(1, 0, At, B0); PG8_BAR; PG8_SCHED;
            PG8_STAGE(PG8_SB(0, 1), b2 + hstepB, voffB);
            PG8_WAIT_V(6); PG8_BAR; PG8_MMA(1, 1, At, B1); PG8_BAR;
            PG8_LDB(B0, 1, 0); PG8_SCHED; PG8_LDA(At, 1, 0); PG8_STAGE(PG8_SA(0, 1), a2 + hstepA, voffA);
            PG8_WAIT_L(8); PG8_BAR; PG8_WAIT_L(0); PG8_MMA(0, 0, At, B0); PG8_BAR; PG8_SCHED;
            PG8_LDB(B1, 1, 1); PG8_STAGE(PG8_SB(1, 0), b3, voffB);
            PG8_BAR; PG8_WAIT_L(0); PG8_MMA(0, 1, At, B1); PG8_BAR;
            PG8_LDA(At, 1, 1); PG8_STAGE(PG8_SA(1, 0), a3, voffA);
            PG8_BAR; PG8_WAIT_L(0); PG8_MMA(1, 0, At, B0); PG8_BAR; PG8_SCHED;
            PG8_STAGE(PG8_SB(1, 1), b3 + hstepB, voffB);
            PG8_WAIT_V(6); PG8_BAR; PG8_MMA(1, 1, At, B1); PG8_BAR;
            }
        }
        if constexpr (ALIGN_EPI) { if (wr == 0) PG8_BAR; }
        if constexpr (SPK) {
            if (cur.tail > 0) {
                unsigned* flag = (unsigned*)(S.spk + WS_CTL) + CW_SPK + (cur.tail - 1) * 16;
                if (wave == 0 && lane_now() == 0) { for (unsigned spins = 0; spins < (1u << 22) && __hip_atomic_load(flag, __ATOMIC_RELAXED, __HIP_MEMORY_SCOPE_AGENT) != (unsigned)S.epoch; ++spins) __builtin_amdgcn_s_sleep(2);
                    __builtin_amdgcn_fence(__ATOMIC_ACQUIRE, "agent"); asm volatile("s_waitcnt vmcnt(0)" ::: "memory"); }
                __syncthreads();
            }
        }
        E(acc, cur, pre, prev_pm, wr, wc, fr, fq);
        if constexpr (SPK) {
            if (cur.tail < 0) {
                unsigned* flag = (unsigned*)(S.spk + WS_CTL) + CW_SPK + (-cur.tail - 1) * 16;
                asm volatile("s_waitcnt vmcnt(0)" ::: "memory");
                __syncthreads();
                if (wave == 0 && lane_now() == 0) { __builtin_amdgcn_fence(__ATOMIC_RELEASE, "agent"); asm volatile("s_waitcnt vmcnt(0)" ::: "memory"); __hip_atomic_store(flag, (unsigned)S.epoch, __ATOMIC_RELAXED, __HIP_MEMORY_SCOPE_AGENT); }
            }
        }
        prev_pm = cur.pm;
        if (!has_next) break;
        E.panel_setup(nxt, prev_pm, tid);
        pre = E.pre_load(nxt, tid);
#pragma unroll
        for (int a = 0; a < 2; ++a)
#pragma unroll
            for (int b = 0; b < 2; ++b)
#pragma unroll
                for (int m = 0; m < 4; ++m)
#pragma unroll
                    for (int n = 0; n < 2; ++n) acc[a][b][m][n] = (f32x4){0.f, 0.f, 0.f, 0.f};
        cur = nxt; cA = nA; cB = nB; ++ui;
        if constexpr (ALIGN_EPI) { if (wr == 1) PG8_BAR; }
    }
    PG8_WAIT_V(0);
    if constexpr (!ALIGN_EPI) { if (wr == 0) PG8_BAR; }
    PG8_BAR;
#undef PG8_KOFS
#undef PG8_SA
#undef PG8_SB
#undef PG8_STAGE
#undef PG8_LDA
#undef PG8_LDB
#undef PG8_MMA
#undef PG8_WAIT_V
#undef PG8_WAIT_L
#undef PG8_BAR
#undef PG8_SCHED
}

struct PreNone { };
struct PreSS { f32x4 v; };
__device__ __forceinline__ PreSS ss_pre_load(const float* SS, const Unit& u, int tid) { PreSS p; p.v = *(const f32x4*)(SS + ((size_t)u.pm * BM + (tid >> 1)) * 8 + (tid & 1) * 4); return p; }
__device__ __forceinline__ void rinv_from_pre(const PreSS& p, bool rebuild, int wr, int wc, int fr, int fq, float (&ri)[8]) {
    LAS float* sl = (LAS float*)(uintptr_t)SSL_OFF;
    if (rebuild) {
        const int t = (wr * 4 + wc) * 64 + fq * 16 + fr;
        asm volatile("s_waitcnt lgkmcnt(0)" ::: "memory"); __builtin_amdgcn_s_barrier(); asm volatile("" ::: "memory");
        sl[t] = (p.v[0] + p.v[1]) + (p.v[2] + p.v[3]);
        asm volatile("s_waitcnt lgkmcnt(0)" ::: "memory"); __builtin_amdgcn_s_barrier(); asm volatile("" ::: "memory");
    }
#pragma unroll
    for (int q = 0; q < 8; ++q) { const f32x2 s = *(const LAS f32x2*)(sl + (wr * 64 + fr + (q >> 2) * HALF + (q & 3) * 16) * 2); ri[q] = __builtin_amdgcn_rsqf((s[0] + s[1]) * (1.0f / D) + EPS); }
}
struct EpiSwiGLU {
    static constexpr bool PERM = true, MIDSCALE = false; typedef PreSS Pre;
    __device__ __forceinline__ void panel_setup(const Unit&, int, int) const {}
    bf16_t* G; int ldg; const float* SS; const float* cb;
    __device__ __forceinline__ Pre pre_load(const Unit& u, int tid) const { return ss_pre_load(SS, u, tid); }
    __device__ __forceinline__ void operator()(f32x4 (&acc)[2][2][4][2], const Unit& u, const Pre& pre, int prev_pm, int wr, int wc, int fr, int fq) const {
        const int row0 = u.pm * BM + wr * 64 + fr, col0 = u.pn * HALF + wc * 32 + 8 * fq;
        const int b = (u.pm < ML / BM) ? (u.pm >> 3) : 16;
        const float* cp = cb + (size_t)b * (2 * DFF) + u.pn * BM + wc * 32 + 8 * fq;
        const f32x4 ca0 = *(const f32x4*)cp, ca1 = *(const f32x4*)(cp + 4), cb0 = *(const f32x4*)(cp + HALF), cb1 = *(const f32x4*)(cp + HALF + 4);
        float rinv[8]; rinv_from_pre(pre, u.pm != prev_pm, wr, wc, fr, fq, rinv);
#pragma unroll
        for (int ai = 0; ai < 2; ++ai)
#pragma unroll
            for (int m = 0; m < 4; ++m) {
                const int row = row0 + ai * HALF + m * 16;
                const float ri = rinv[ai * 4 + m];
                bf16_t* rowp = G + (size_t)row * ldg + col0;
                const f32x4 a0 = acc[ai][0][m][0] * ri + ca0, a1 = acc[ai][0][m][1] * ri + ca1, b0 = acc[ai][1][m][0] * ri + cb0, b1 = acc[ai][1][m][1] * ri + cb1;
                float g[8];
#pragma unroll
                for (int i = 0; i < 4; ++i) { g[i] = silu_f(a0[i]) * b0[i]; g[4 + i] = silu_f(a1[i]) * b1[i]; }
                u32x4 w; w.x = cvt_pk_bf16(g[0], g[1]); w.y = cvt_pk_bf16(g[2], g[3]); w.z = cvt_pk_bf16(g[4], g[5]); w.w = cvt_pk_bf16(g[6], g[7]);
                *(u32x4*)rowp = w;
            }
    }
};
template <bool MS> struct EpiResid {
    static constexpr bool PERM = true, MIDSCALE = MS; typedef PreNone Pre;
    __device__ __forceinline__ Pre pre_load(const Unit&, int) const { return Pre{}; }
    __device__ __forceinline__ void panel_setup(const Unit& u, int prev_pm, int tid) const {
        if constexpr (MS) { if (u.pm != prev_pm || u.tail < 0) {
            LAS f32x2* tb = (LAS f32x2*)(uintptr_t)(SSL_OFF + 8192);
            asm volatile("s_waitcnt lgkmcnt(0)" ::: "memory"); __builtin_amdgcn_s_barrier(); asm volatile("" : "+v"(tid) :: "memory");
            if (tid < BM) { const float* sp = (const float*)(ws + WS_BIG + BG_KRF) + ((size_t)u.pm * BM + tid) * 16;
                const f32x4 a0 = *(const f32x4*)sp, a1 = *(const f32x4*)(sp + 4), b0 = *(const f32x4*)(sp + 8), b1 = *(const f32x4*)(sp + 12);
                const float ra = __builtin_amdgcn_rsqf((((a0[0] + a0[1]) + (a0[2] + a0[3])) + ((a1[0] + a1[1]) + (a1[2] + a1[3]))) * (1.0f / 1024.f) + EPS);
                const float rb = __builtin_amdgcn_rsqf((((b0[0] + b0[1]) + (b0[2] + b0[3])) + ((b1[0] + b1[1]) + (b1[2] + b1[3]))) * (1.0f / 1024.f) + EPS);
                tb[tid] = (f32x2){ra / rb, u.tail < 0 ? ra : rb}; }
            asm volatile("s_waitcnt lgkmcnt(0)" ::: "memory"); __builtin_amdgcn_s_barrier(); asm volatile("" ::: "memory");
        } }
    }
    __device__ __forceinline__ void mid(f32x4 (&acc)[2][2][4][2], int wr, int fr) const {
        const LAS f32x2* tb = (const LAS f32x2*)(uintptr_t)(SSL_OFF + 8192);
#pragma unroll
        for (int ai = 0; ai < 2; ++ai)
#pragma unroll
            for (int m = 0; m < 4; ++m) { const float r = tb[wr * 64 + fr + ai * HALF + m * 16][0];
#pragma unroll
                for (int bj = 0; bj < 2; ++bj) { acc[ai][bj][m][0] *= r; acc[ai][bj][m][1] *= r; } }
    }
    unsigned char* ws; float* out;
    int l, gidx; float scale; int emit, nvec, ln, sidxn, dst_out;
    __device__ __forceinline__ void operator()(f32x4 (&acc)[2][2][4][2], const Unit& u, const Pre&, int, int wr, int wc, int fr, int fq) const {
        const int emit_ = (u.tail < 0) ? 0 : emit;
        unsigned char* w_ = ws; float* o_ = out; asm volatile("" : "+s"(w_), "+s"(o_));
        { const int ln_ = lane_now(); fr = ln_ & 15; fq = ln_ >> 4; }
        const float* modl = (const float*)(w_ + WS_MOD) + (size_t)l * 17 * NMOD; const float* modn = (const float*)(w_ + WS_MOD) + (size_t)ln * 17 * NMOD;
        const float* gn = (const float*)(w_ + WS_SMALL) + nvec; float* SS = (float*)(w_ + WS_SS);
        LAS float* ssl = (LAS float*)(uintptr_t)SSL_OFF;
        const bool lat = u.pm < ML / BM;
        const int b = lat ? (u.pm >> 3) : 16;
        const float* gate = modl + (size_t)b * NMOD + gidx * D;
        const int col0 = u.pn * BM + wc * 32 + 8 * fq, r0 = wr * 64 + fr;
        const unsigned e0 = (unsigned)(r0 * D + col0);
        GAS char* hb = (GAS char*)(w_ + WS_H16) + (size_t)u.pm * BM * D * 2;
        GAS char* xnb = (GAS char*)(w_ + WS_XN) + (size_t)u.pm * BM * XNP * 2;
        const unsigned e0x = (unsigned)(r0 * XNP + col0);
        GAS float* ob = (GAS float*)o_ + (size_t)u.pm * BM * D;
        if constexpr (MS) { const LAS f32x2* tb = (const LAS f32x2*)(uintptr_t)(SSL_OFF + 8192);
#pragma unroll
            for (int ai = 0; ai < 2; ++ai)
#pragma unroll
                for (int m = 0; m < 4; ++m) { const float r = tb[r0 + ai * HALF + m * 16][1];
#pragma unroll
                    for (int bj = 0; bj < 2; ++bj) { acc[ai][bj][m][0] *= r; acc[ai][bj][m][1] *= r; } } }
#pragma unroll
        for (int bj = 0; bj < 2; ++bj) {
            const int c = col0 + bj * HALF;
            const f32x4 gv0 = *(const f32x4*)(gate + c) * scale, gv1 = *(const f32x4*)(gate + c + 4) * scale;
#pragma unroll
            for (int ai = 0; ai < 2; ++ai) {
                u32x4 s[4];
#pragma unroll
                for (int m = 0; m < 4; ++m) s[m] = *(const GAS u32x4*)((hb + (size_t)(((ai * HALF + m * 16) * D + bj * HALF) * 2)) + e0 * 2u);
#pragma unroll
                for (int m = 0; m < 4; ++m) { f32x4 s0, s1; h8_to_f32(s[m], s0, s1);
                    acc[ai][bj][m][0] = s0 + gv0 * acc[ai][bj][m][0]; acc[ai][bj][m][1] = s1 + gv1 * acc[ai][bj][m][1]; }
            }
            asm volatile("" ::: "memory");
        }
        if (dst_out) {
            float sq[8];
#pragma unroll
            for (int q = 0; q < 8; ++q) { sq[q] = 0.f;
#pragma unroll
                for (int bj = 0; bj < 2; ++bj) { const f32x4 h0 = acc[q >> 2][bj][q & 3][0], h1 = acc[q >> 2][bj][q & 3][1];
                    sq[q] += ((h0[0] * h0[0] + h0[1] * h0[1]) + (h0[2] * h0[2] + h0[3] * h0[3])) + ((h1[0] * h1[0] + h1[1] * h1[1]) + (h1[2] * h1[2] + h1[3] * h1[3])); } }
            { const int ln2 = lane_now(), r0b = wr * 64 + (ln2 & 15);
#pragma unroll
              for (int q = 0; q < 8; ++q) { float v = sq[q]; v += shfl_xor_f(v, 16, ln2); v += shfl_xor_f(v, 32, ln2); if (ln2 < 16) ssl[(r0b + (q >> 2) * HALF + (q & 3) * 16) * 4 + wc] = v; } }
            asm volatile("s_waitcnt lgkmcnt(0)" ::: "memory"); __builtin_amdgcn_s_barrier(); asm volatile("" ::: "memory");
            const int t = (wr * 4 + wc) * 64 + lane_now();
            if (t < BM) { const f32x4 p = *(const LAS f32x4*)(ssl + t * 4); SS[((size_t)u.pm * BM + t) * 8 + u.pn] = (p[0] + p[1]) + (p[2] + p[3]); }
            asm volatile("s_waitcnt vmcnt(0)" ::: "memory");
            __syncthreads();
            if (t == 0) { unsigned* cnt = (unsigned*)(w_ + WS_CTL) + CW_FIN + u.pm * 16;
                __builtin_amdgcn_fence(__ATOMIC_RELEASE, "agent"); asm volatile("s_waitcnt vmcnt(0)" ::: "memory");
                __hip_atomic_fetch_add(cnt, 1u, __ATOMIC_RELAXED, __HIP_MEMORY_SCOPE_AGENT);
                for (unsigned spins = 0; spins < (1u << 22) && __hip_atomic_load(cnt, __ATOMIC_RELAXED, __HIP_MEMORY_SCOPE_AGENT) < 8u; ++spins) __builtin_amdgcn_s_sleep(2);
                __builtin_amdgcn_fence(__ATOMIC_ACQUIRE, "agent"); asm volatile("s_waitcnt vmcnt(0)" ::: "memory"); }
            __syncthreads();
            if (t < BM) { const float* sp = SS + ((size_t)u.pm * BM + t) * 8; const f32x4 a = *(const f32x4*)sp, b2 = *(const f32x4*)(sp + 4);
                ssl[t] = 1.0f / sqrtf((((a[0] + a[1]) + (a[2] + a[3])) + ((b2[0] + b2[1]) + (b2[2] + b2[3]))) * (1.0f / D) + EPS); }
            asm volatile("s_waitcnt lgkmcnt(0)" ::: "memory"); __builtin_amdgcn_s_barrier(); asm volatile("" ::: "memory");
            const float* gf = (const float*)(w_ + WS_SMALL) + SM_FINN;
            float ri[8];
            { const int r0c = wr * 64 + (lane_now() & 15);
#pragma unroll
              for (int q = 0; q < 8; ++q) ri[q] = ssl[r0c + (q >> 2) * HALF + (q & 3) * 16]; }
#pragma unroll
            for (int bj = 0; bj < 2; ++bj) { const int c = col0 + bj * HALF; const f32x4 g0 = *(const f32x4*)(gf + c), g1 = *(const f32x4*)(gf + c + 4);
#pragma unroll
                for (int q = 0; q < 8; ++q) { const size_t co = (size_t)(((q >> 2) * HALF + (q & 3) * 16) * D + bj * HALF);
                    const f32x4 h0 = acc[q >> 2][bj][q & 3][0] * ri[q] * g0, h1 = acc[q >> 2][bj][q & 3][1] * ri[q] * g1;
                    *(GAS f32x4*)((GAS char*)(ob + co) + e0 * 4u) = h0; *(GAS f32x4*)((GAS char*)(ob + co + 4) + e0 * 4u) = h1; } }
            return;
        }
        float ssq[8];
#pragma unroll
        for (int q = 0; q < 8; ++q) ssq[q] = 0.f;
#pragma unroll
        for (int bj = 0; bj < 2; ++bj) {
            f32x4 gs0 = (f32x4){0.f, 0.f, 0.f, 0.f}, gs1 = gs0;
            if (emit_) { const int c = col0 + bj * HALF; const float* mp = modn + (size_t)b * NMOD + sidxn * D + c; gs0 = *(const f32x4*)(gn + c) * (*(const f32x4*)mp + 1.0f); gs1 = *(const f32x4*)(gn + c + 4) * (*(const f32x4*)(mp + 4) + 1.0f); }
#pragma unroll
            for (int q = 0; q < 8; ++q) { const size_t co = (size_t)(((q >> 2) * HALF + (q & 3) * 16) * D + bj * HALF);
                const f32x4 h0 = acc[q >> 2][bj][q & 3][0], h1 = acc[q >> 2][bj][q & 3][1];
                { u32x4 hv; hv.x = cvt_pk_f16(h0[0], h0[1]); hv.y = cvt_pk_f16(h0[2], h0[3]); hv.z = cvt_pk_f16(h1[0], h1[1]); hv.w = cvt_pk_f16(h1[2], h1[3]); *(GAS u32x4*)((hb + co * 2) + e0 * 2u) = hv; }
                if (emit_) { ssq[q] += ((h0[0] * h0[0] + h0[1] * h0[1]) + (h0[2] * h0[2] + h0[3] * h0[3])) + ((h1[0] * h1[0] + h1[1] * h1[1]) + (h1[2] * h1[2] + h1[3] * h1[3]));
                    const f32x4 a0 = h0 * gs0, a1 = h1 * gs1;
                    u32x4 w; w.x = cvt_pk_bf16(a0[0], a0[1]); w.y = cvt_pk_bf16(a0[2], a0[3]); w.z = cvt_pk_bf16(a1[0], a1[1]); w.w = cvt_pk_bf16(a1[2], a1[3]); *(GAS u32x4*)((xnb + (size_t)(((q >> 2) * HALF + (q & 3) * 16) * XNP + bj * HALF) * 2) + e0x * 2u) = w; } }
        }
        if (emit_) {
#pragma unroll
            for (int q = 0; q < 8; ++q) { float v = ssq[q]; v += shfl_xor_f(v, 16, fq * 16 + fr); v += shfl_xor_f(v, 32, fq * 16 + fr); if (fq == 0) ssl[(r0 + (q >> 2) * HALF + (q & 3) * 16) * 4 + wc] = v; }
        }
        if (emit_) {
            asm volatile("s_waitcnt lgkmcnt(0)" ::: "memory"); __builtin_amdgcn_s_barrier(); asm volatile("" ::: "memory");
            const int t = (wr * 4 + wc) * 64 + fq * 16 + fr;
            if (t < BM) { const f32x4 p = *(const LAS f32x4*)(ssl + t * 4); SS[((size_t)u.pm * BM + t) * 8 + u.pn] = (p[0] + p[1]) + (p[2] + p[3]); }
        }
    }
};
template <bool P> struct EpiNull {
    static constexpr bool PERM = P, MIDSCALE = false; typedef PreNone Pre;
    __device__ __forceinline__ void panel_setup(const Unit&, int, int) const {}
    __device__ __forceinline__ Pre pre_load(const Unit&, int) const { return Pre{}; }
    __device__ __forceinline__ void operator()(f32x4 (&acc)[2][2][4][2], const Unit&, const Pre&, int, int, int, int, int) const {
#pragma unroll
        for (int ai = 0; ai < 2; ++ai)
#pragma unroll
            for (int bj = 0; bj < 2; ++bj) asm volatile("" :: "v"(acc[ai][bj][0][0]), "v"(acc[ai][bj][0][1]), "v"(acc[ai][bj][1][0]), "v"(acc[ai][bj][1][1]), "v"(acc[ai][bj][2][0]), "v"(acc[ai][bj][2][1]), "v"(acc[ai][bj][3][0]), "v"(acc[ai][bj][3][1]));
    }
};
struct EpiWin {
    static constexpr bool PERM = true, MIDSCALE = false; typedef PreSS Pre;
    __device__ __forceinline__ void panel_setup(const Unit&, int, int) const {}
    bf16_t* CQKV; bf16_t* NQKV; bf16_t* KR; float* SSQ4; const float* SS; const float* cb; const float* cosT;
    __device__ __forceinline__ Pre pre_load(const Unit& u, int tid) const { return ss_pre_load(SS, u, tid); }
    __device__ __forceinline__ void operator()(f32x4 (&acc)[2][2][4][2], const Unit& u, const Pre& pre, int prev_pm, int wr, int wc, int fr, int fq) const {
        const int row0 = u.pm * BM + wr * 64 + fr;
        const int b = (u.pm < ML / BM) ? (u.pm >> 3) : 16;
        const float* cp = cb + (size_t)b * PINP + u.pn * BM + wc * 32 + 8 * fq;
        f32x4 cv[2][2];
#pragma unroll
        for (int bj = 0; bj < 2; ++bj)
#pragma unroll
            for (int n = 0; n < 2; ++n) cv[bj][n] = *(const f32x4*)(cp + bj * HALF + 4 * n);
        bf16_t* base = CQKV; int colt = u.pn * BM;
        if (u.pn >= 4) { const int t = (u.pn - 4) >> 2; base = NQKV + (size_t)t * MT * 1024; colt = ((u.pn - 4) & 3) * BM; }
        const int col0 = colt + wc * 32 + 8 * fq;
        float rinv[8]; rinv_from_pre(pre, u.pm != prev_pm, wr, wc, fr, fq, rinv);
        LAS float* sq = (LAS float*)(uintptr_t)(SSL_OFF + 4096);
#pragma unroll
        for (int ai = 0; ai < 2; ++ai)
#pragma unroll
            for (int m = 0; m < 4; ++m) { const int row = row0 + ai * HALF + m * 16;
                const float ri = rinv[ai * 4 + m];
                if (u.pn < 16) { bf16_t* rowp = base + (size_t)row * 1024 + col0; float ssq = 0.f;
#pragma unroll
                    for (int bj = 0; bj < 2; ++bj) { const f32x4 v0 = acc[ai][bj][m][0] * ri + cv[bj][0], v1 = acc[ai][bj][m][1] * ri + cv[bj][1];
                        ssq += ((v0[0] * v0[0] + v0[1] * v0[1]) + (v0[2] * v0[2] + v0[3] * v0[3])) + ((v1[0] * v1[0] + v1[1] * v1[1]) + (v1[2] * v1[2] + v1[3] * v1[3]));
                        u32x4 w; w.x = cvt_pk_bf16(v0[0], v0[1]); w.y = cvt_pk_bf16(v0[2], v0[3]); w.z = cvt_pk_bf16(v1[0], v1[1]); w.w = cvt_pk_bf16(v1[2], v1[3]);
                        *(u32x4*)(rowp + bj * HALF) = w; }
                    if (u.pn < 4) { ssq += shfl_xor_f(ssq, 16, fq * 16 + fr); ssq += shfl_xor_f(ssq, 32, fq * 16 + fr); if (fq == 0) sq[(wr * 64 + fr + ai * HALF + m * 16) * 4 + wc] = ssq; }
                } else if (wc < 2) {
                    f32x4 a = acc[ai][0][m][0] * ri + cv[0][0], bq = acc[ai][0][m][1] * ri + cv[0][1];
                    if (u.pm < ML / BM) { const int t = row & (SEQ - 1); const int pos = wc ? (t & 63) : (t >> 6);
                        const f32x4 cs = *(const f32x4*)(cosT + pos * 16 + 4 * fq), sn = *(const f32x4*)(cosT + 1024 + pos * 16 + 4 * fq);
                        const f32x4 a2 = a * cs - bq * sn, b2 = a * sn + bq * cs; a = a2; bq = b2; }
                    u32x4 w; w.x = cvt_pk_bf16(a[0], a[1]); w.y = cvt_pk_bf16(a[2], a[3]); w.z = cvt_pk_bf16(bq[0], bq[1]); w.w = cvt_pk_bf16(bq[2], bq[3]);
                    *(u32x4*)(KR + (size_t)row * 64 + wc * 32 + 8 * fq) = w; }
            }
        if (u.pn < 4) {
            asm volatile("s_waitcnt lgkmcnt(0)" ::: "memory"); __builtin_amdgcn_s_barrier(); asm volatile("" ::: "memory");
            const int t = (wr * 4 + wc) * 64 + fq * 16 + fr;
            if (t < BM) { const f32x4 p = *(const LAS f32x4*)(sq + t * 4); SSQ4[((size_t)u.pm * BM + t) * 4 + u.pn] = (p[0] + p[1]) + (p[2] + p[3]); }
        }
    }
};
struct EpiUp {
    static constexpr bool PERM = true, MIDSCALE = false; typedef PreNone Pre;
    __device__ __forceinline__ void panel_setup(const Unit&, int, int) const {}
    bf16_t* Q; bf16_t* KV; const float* SSQ4; const float* cosT; const float* sinT;
    __device__ __forceinline__ Pre pre_load(const Unit&, int) const { return Pre{}; }
    __device__ __forceinline__ void operator()(f32x4 (&acc)[2][2][4][2], const Unit& u, const Pre&, int, int wr, int wc, int fr, int fq) const {
        const int row0 = u.pm * BM + wr * 64 + fr;
        const bool isq = u.pn < 6; const bool lat = u.pm < ML / BM;
        bf16_t* base = isq ? Q : KV; const int ld = isq ? QW : KVW; const int colt = isq ? u.pn * BM : (u.pn - 6) * BM;
        const int col0 = colt + wc * 32 + 8 * fq;
#pragma unroll
        for (int ai = 0; ai < 2; ++ai)
#pragma unroll
            for (int m = 0; m < 4; ++m) { const int row = row0 + ai * HALF + m * 16; const f32x2 sq2 = *(const f32x2*)(SSQ4 + (size_t)row * 4 + (isq ? 0 : 2)); const float ri = __builtin_amdgcn_rsqf((sq2[0] + sq2[1]) * (1.0f / 512.f) + EPS);
                bf16_t* rowp = base + (size_t)row * ld + col0;
#pragma unroll
                for (int bj = 0; bj < 2; ++bj) { f32x4 v0 = acc[ai][bj][m][0] * ri, v1 = acc[ai][bj][m][1] * ri;
                    const int c32 = (u.pn * 8 + bj * 4 + wc) % 6;
                    if (isq && lat && c32 >= 4) { const int t = row & (SEQ - 1); const int pos = (c32 == 4) ? (t >> 6) : (t & 63);
                        const f32x4 cs = *(const f32x4*)(cosT + pos * 16 + 4 * fq), sn = *(const f32x4*)(sinT + pos * 16 + 4 * fq);
                        const f32x4 a = v0, b = v1; v0 = a * cs - b * sn; v1 = a * sn + b * cs; }
                    u32x4 w; w.x = cvt_pk_bf16(v0[0], v0[1]); w.y = cvt_pk_bf16(v0[2], v0[3]); w.z = cvt_pk_bf16(v1[0], v1[1]); w.w = cvt_pk_bf16(v1[2], v1[3]);
                    *(u32x4*)(rowp + bj * HALF) = w; } }
    }
};
}

namespace att {
constexpr int KN_B = 16384, KR_B = 8192, V_B = 16384, SLOT = KN_B + KR_B + V_B, NSLOT = 3;
constexpr int KN_OFF = 0, KR_OFF = KN_B, V_OFF = KN_B + KR_B;
constexpr int SCR_OFF = NSLOT * SLOT;
constexpr int BIAS_OFF = SCR_OFF + 2048;
constexpr int OST_OFF = BIAS_OFF + 2048;
static_assert(OST_OFF + 8 * 2048 <= LDSCTL_OFF, "attention LDS");
constexpr float THR = 8.f;
#define SBAR() __builtin_amdgcn_sched_barrier(0)
__device__ __forceinline__ int crow(int r, int hi) { return (r & 3) + 8 * (r >> 2) + 4 * hi; }

__device__ __forceinline__ void partialSM(f32x16& p0, f32x16& p1, float& m_reg, float& mn, float& alpha, const float C, const float thr) {
    float pmax = p0[0];
#pragma unroll
    for (int r = 1; r < 16; ++r) pmax = fmaxf(pmax, p0[r]);
#pragma unroll
    for (int r = 0; r < 16; ++r) pmax = fmaxf(pmax, p1[r]);
    { auto rr = __builtin_amdgcn_permlane32_swap(__float_as_uint(pmax), __float_as_uint(pmax), false, false);
      pmax = fmaxf(__uint_as_float(rr[0]), __uint_as_float(rr[1])); }
    if (__builtin_expect(__all(pmax - m_reg <= thr), 1)) { mn = m_reg; alpha = 1.f; }
    else { mn = fmaxf(m_reg, pmax); alpha = __builtin_amdgcn_exp2f((m_reg - mn) * C); m_reg = mn; }
    const float mnC = -mn * C;
#pragma unroll
    for (int r = 0; r < 16; ++r) p0[r] = __builtin_amdgcn_exp2f(fmaf(p0[r], C, mnC));
#pragma unroll
    for (int r = 0; r < 16; ++r) p1[r] = __builtin_amdgcn_exp2f(fmaf(p1[r], C, mnC));
}
__device__ __forceinline__ void finishSM(const f32x16& p0, const f32x16& p1, float alpha, float& l_reg, bf16x8& pa0, bf16x8& pa1, bf16x8& pa2, bf16x8& pa3) {
    float ps = 0;
#pragma unroll
    for (int r = 0; r < 16; ++r) ps += p0[r];
#pragma unroll
    for (int r = 0; r < 16; ++r) ps += p1[r];
    { auto rr = __builtin_amdgcn_permlane32_swap(__float_as_uint(ps), __float_as_uint(ps), false, false);
      ps = __uint_as_float(rr[0]) + __uint_as_float(rr[1]); }
    l_reg = l_reg * alpha + ps;
#define PK4(P, BASE, OUT) do { unsigned a0 = cvt_pk_bf16(P[BASE + 0], P[BASE + 1]), a1 = cvt_pk_bf16(P[BASE + 2], P[BASE + 3]);   \
    unsigned b0 = cvt_pk_bf16(P[BASE + 4], P[BASE + 5]), b1 = cvt_pk_bf16(P[BASE + 6], P[BASE + 7]);                              \
    auto r0 = __builtin_amdgcn_permlane32_swap(a0, b0, false, false); auto r1 = __builtin_amdgcn_permlane32_swap(a1, b1, false, false); \
    u32x4 w = {r0[0], r1[0], r0[1], r1[1]}; OUT = __builtin_bit_cast(bf16x8, w); } while (0)
    PK4(p0, 0, pa0); PK4(p0, 8, pa1); PK4(p1, 0, pa2); PK4(p1, 8, pa3);
#undef PK4
}
__device__ __forceinline__ int v_rd_base(int lane) { return ((lane & 3) << 3) | (((lane >> 2) & 3) << 6) | (((lane >> 4) & 1) << 5) | (((lane >> 5) & 1) << 8); }
constexpr int v_rd_off(int d0, int ks, int half) { return d0 * 512 + ks * 4096 + half * 2048; }
template <int OFF> __device__ __forceinline__ s16x4 tr_read(unsigned vb) {
    s16x4 r; asm volatile("ds_read_b64_tr_b16 %0, %1 offset:%2" : "=&v"(r) : "v"(vb), "i"(OFF) : "memory"); return r;
}
template <int D0> __device__ __forceinline__ void pv_one(f32x16& od, unsigned vb, bf16x8 pa0, bf16x8 pa1, bf16x8 pa2, bf16x8 pa3) {
    const s16x4 l0 = tr_read<v_rd_off(D0, 0, 0)>(vb), h0 = tr_read<v_rd_off(D0, 0, 1)>(vb), l1 = tr_read<v_rd_off(D0, 1, 0)>(vb), h1 = tr_read<v_rd_off(D0, 1, 1)>(vb);
    const s16x4 l2 = tr_read<v_rd_off(D0, 2, 0)>(vb), h2 = tr_read<v_rd_off(D0, 2, 1)>(vb), l3 = tr_read<v_rd_off(D0, 3, 0)>(vb), h3 = tr_read<v_rd_off(D0, 3, 1)>(vb);
    asm volatile("s_waitcnt lgkmcnt(0)" ::: "memory"); SBAR();
#define PK(L, H) (bf16x8){L[0], L[1], L[2], L[3], H[0], H[1], H[2], H[3]}
    od = __builtin_amdgcn_mfma_f32_32x32x16_bf16(pa0, PK(l0, h0), od, 0, 0, 0);
    od = __builtin_amdgcn_mfma_f32_32x32x16_bf16(pa1, PK(l1, h1), od, 0, 0, 0);
    od = __builtin_amdgcn_mfma_f32_32x32x16_bf16(pa2, PK(l2, h2), od, 0, 0, 0);
    od = __builtin_amdgcn_mfma_f32_32x32x16_bf16(pa3, PK(l3, h3), od, 0, 0, 0);
#undef PK
}
__device__ __forceinline__ int swap23(int k) { return (k & ~0xC) | ((k & 4) << 1) | ((k & 8) >> 1); }

template <int DQK, bool NA>
__device__ __forceinline__ void attn_unit(LAS unsigned char* lds, const int wave,
        const bf16_t* __restrict__ Qp, const int ldq, const bf16_t* __restrict__ Knb, const bf16_t* __restrict__ Vb, const int ldkv, const bf16_t* __restrict__ Krb,
        const int base1, const int n1, const int base2, const int n2, const float scale, bf16_t* __restrict__ Op, const int ldo,
        const float* __restrict__ rpb_h, const int strip0, const int qgr0, float* __restrict__ ssa  ) {
    constexpr int ND = DQK / 16;
    const int tid = opaque_tid(wave), lane = tid & 63, wid = __builtin_amdgcn_readfirstlane(tid >> 6);
    const int r32 = lane & 31, hi = lane >> 5;
    LAS float* wsf = (LAS float*)(lds + SCR_OFF) + wid * 64; LAS float* li_l = wsf; LAS float* al_l = wsf + 32;
    LAS float* bias_l = (LAS float*)(lds + BIAS_OFF);
    unsigned okn[2], ov[2], okr;
#pragma unroll
    for (int i = 0; i < 2; ++i) { const int q = i * 512 + tid; const int row = q >> 4, cs = q & 15; okn[i] = (unsigned)(row * ldkv * 2 + ((cs ^ (row & 15)) << 4)); }
#pragma unroll
    for (int i = 0; i < 2; ++i) { const int q = i * 512 + tid; const int sub = q >> 5; const int kk = (sub >> 2) * 8 + ((q & 31) >> 2), c = (sub & 3) * 32 + (q & 3) * 8; ov[i] = (unsigned)(swap23(kk) * ldkv * 2 + c * 2); }
    { const int q = tid; const int row = q >> 3, cs = q & 7; okr = (unsigned)(row * 128 + ((cs ^ ((row >> 1) & 7)) << 4)); }
    const int nt = n1 + n2;
    __syncthreads();
    if (NA) { for (int i = tid; i < 465; i += 512) bias_l[i] = rpb_h[i]; }
    bf16x8 qr[ND];
    { const bf16_t* Qw = Qp + (size_t)(wid * 32 + r32) * ldq + hi * 8;
#pragma unroll
      for (int d0 = 0; d0 < ND; ++d0) qr[d0] = *(const bf16x8*)(Qw + d0 * 16); }
#define ATT_TROW(j_) ((j_) < n1 ? base1 + 64 * (j_) : base2 + 64 * ((j_) - n1))
#define ATT_ISSUE(j_, slot_) do { const size_t tr_ = (size_t)ATT_TROW(j_); LAS unsigned char* sl_ = lds + (slot_) * SLOT + wid * 1024; \
        const char* kb_ = (const char*)Knb + tr_ * (size_t)ldkv * 2; const char* vb_ = (const char*)Vb + tr_ * (size_t)ldkv * 2; \
        __builtin_amdgcn_global_load_lds((const unsigned*)(kb_ + okn[0]), (LAS unsigned*)(sl_ + KN_OFF), 16, 0, 0); \
        __builtin_amdgcn_global_load_lds((const unsigned*)(kb_ + okn[1]), (LAS unsigned*)(sl_ + KN_OFF + 8192), 16, 0, 0); \
        __builtin_amdgcn_global_load_lds((const unsigned*)(vb_ + ov[0]), (LAS unsigned*)(sl_ + V_OFF), 16, 0, 0); \
        __builtin_amdgcn_global_load_lds((const unsigned*)(vb_ + ov[1]), (LAS unsigned*)(sl_ + V_OFF + 8192), 16, 0, 0); \
        if (DQK == 192) __builtin_amdgcn_global_load_lds((const unsigned*)((const char*)Krb + tr_ * 128 + okr), (LAS unsigned*)(sl_ + KR_OFF), 16, 0, 0); } while (0)
    if (NA) { ATT_ISSUE(0, 0); if (nt > 1) ATT_ISSUE(1, 1); } else { ATT_ISSUE(0, 0); }
    float m_reg = -1e30f, l_reg = 0.f;
    f32x16 o[4];
#pragma unroll
    for (int d = 0; d < 4; ++d)
#pragma unroll
        for (int r = 0; r < 16; ++r) o[d][r] = 0.f;
    const int gr = qgr0 + (wid >> 1), rs = min(max(gr - 4, 0), 24);
    const int qc = (wid & 1) * 32 + r32, cs0 = min(max(qc - 8, 0), 48);
    const unsigned lds_u = (unsigned)(unsigned long)lds;
    if constexpr (!NA) {
        const float C = scale * 1.4426950408889634f, thr = THR / scale;
        f32x16 pA0, pA1, pB0, pB1; float alA = 1.f, alB = 1.f, mnT;
#define T15_QK(sb_, P0, P1) do { \
            _Pragma("unroll") for (int r = 0; r < 16; ++r) { P0[r] = 0.f; P1[r] = 0.f; } \
            bf16x8 kf0[2], kf1[2]; \
            const unsigned ka = (sb_) + KN_OFF + r32 * 256, kx = (unsigned)((r32 & 15) << 4); \
            const unsigned ra = (sb_) + KR_OFF + r32 * 128, rx = (unsigned)((r32 >> 1) & 7); \
            kf0[0] = *(const LAS bf16x8*)(ka + ((unsigned)(hi * 16) ^ kx)); kf1[0] = *(const LAS bf16x8*)(ka + 32 * 256 + ((unsigned)(hi * 16) ^ kx)); \
            _Pragma("unroll") for (int d0 = 0; d0 < ND; ++d0) { \
                if (d0 + 1 < 8) { const unsigned cb = (unsigned)(((d0 + 1) * 16 + hi * 8) * 2) ^ kx; kf0[(d0 + 1) & 1] = *(const LAS bf16x8*)(ka + cb); kf1[(d0 + 1) & 1] = *(const LAS bf16x8*)(ka + 32 * 256 + cb); } \
                else if (d0 + 1 < ND) { const unsigned ch = ((unsigned)((d0 + 1 - 8) * 2 + hi) ^ rx) << 4; kf0[(d0 + 1) & 1] = *(const LAS bf16x8*)(ra + ch); kf1[(d0 + 1) & 1] = *(const LAS bf16x8*)(ra + 32 * 128 + ch); } \
                P0 = __builtin_amdgcn_mfma_f32_32x32x16_bf16(kf0[d0 & 1], qr[d0], P0, 0, 0, 0); \
                P1 = __builtin_amdgcn_mfma_f32_32x32x16_bf16(kf1[d0 & 1], qr[d0], P1, 0, 0, 0); } } while (0)
#define T15_RESC(a_) do { if (__any((a_) < 1.f)) { if (hi == 0) al_l[r32] = (a_); asm volatile("s_waitcnt lgkmcnt(0)" ::: "memory"); \
            _Pragma("unroll") for (int r = 0; r < 16; ++r) { const float a = al_l[crow(r, hi)]; _Pragma("unroll") for (int d = 0; d < 4; ++d) o[d][r] *= a; } } } while (0)
#define T15_TOP(j_, sn_) do { asm volatile("s_waitcnt vmcnt(0)" ::: "memory"); asm volatile("s_waitcnt lgkmcnt(0)" ::: "memory"); __builtin_amdgcn_s_barrier(); asm volatile("" ::: "memory"); \
            if ((j_) + 1 < nt) ATT_ISSUE((j_) + 1, sn_); } while (0)
#define T15_STEP(j_, sc_, so_, sn_, PN0, PN1, AN, PO0, PO1, AO) do { \
            T15_TOP(j_, sn_); \
            bf16x8 pa0, pa1, pa2, pa3; \
            SBAR(); T15_QK(lds_u + (sc_) * SLOT, PN0, PN1); finishSM(PO0, PO1, AO, l_reg, pa0, pa1, pa2, pa3); SBAR(); \
            { const unsigned vb = lds_u + (so_) * SLOT + V_OFF + v_rd_base(lane); \
              pv_one<0>(o[0], vb, pa0, pa1, pa2, pa3); pv_one<1>(o[1], vb, pa0, pa1, pa2, pa3); pv_one<2>(o[2], vb, pa0, pa1, pa2, pa3); pv_one<3>(o[3], vb, pa0, pa1, pa2, pa3); } \
            partialSM(PN0, PN1, m_reg, mnT, AN, C, thr); \
            T15_RESC(AN); } while (0)
        T15_TOP(0, 1);
        T15_QK(lds_u, pA0, pA1); partialSM(pA0, pA1, m_reg, mnT, alA, C, thr); T15_RESC(alA);
        int sc = 1, so = 0, sn = 2;
        for (int j = 1; j < nt; j += 2) {
            T15_STEP(j, sc, so, sn, pB0, pB1, alB, pA0, pA1, alA);
            { const int t = so; so = sc; sc = sn; sn = t; }
            if (j + 1 < nt) {
                T15_STEP(j + 1, sc, so, sn, pA0, pA1, alA, pB0, pB1, alB);
                { const int t = so; so = sc; sc = sn; sn = t; }
            }
        }
        {
            bf16x8 pa0, pa1, pa2, pa3;
            if ((nt & 1) == 0) finishSM(pB0, pB1, alB, l_reg, pa0, pa1, pa2, pa3); else finishSM(pA0, pA1, alA, l_reg, pa0, pa1, pa2, pa3);
            const unsigned vb = lds_u + so * SLOT + V_OFF + v_rd_base(lane);
            pv_one<0>(o[0], vb, pa0, pa1, pa2, pa3); pv_one<1>(o[1], vb, pa0, pa1, pa2, pa3); pv_one<2>(o[2], vb, pa0, pa1, pa2, pa3); pv_one<3>(o[3], vb, pa0, pa1, pa2, pa3);
        }
#undef T15_QK
#undef T15_RESC
#undef T15_TOP
#undef T15_STEP
    } else {
    int slot = 0, slot2 = 2;
    for (int j = 0; j < nt; ++j) {
        if (j + 1 < nt) { if (DQK == 192) asm volatile("s_waitcnt vmcnt(5)" ::: "memory"); else asm volatile("s_waitcnt vmcnt(4)" ::: "memory"); }
        else asm volatile("s_waitcnt vmcnt(0)" ::: "memory");
        asm volatile("s_waitcnt lgkmcnt(0)" ::: "memory");
        __builtin_amdgcn_s_barrier();
        asm volatile("" ::: "memory");
        if (j + 2 < nt) ATT_ISSUE(j + 2, slot2);
        bool active = true; int dr = 0;
        if (NA && j < n1) { const int kr = strip0 + j; active = (kr >= rs) && (kr < rs + 8); dr = kr - gr + 7; }
        if (active) {
            const unsigned sb = lds_u + slot * SLOT;
            f32x16 p0, p1;
#pragma unroll
            for (int r = 0; r < 16; ++r) { p0[r] = 0.f; p1[r] = 0.f; }
            {
                bf16x8 kf0[2], kf1[2];
                const unsigned ka = sb + KN_OFF + r32 * 256, kx = (unsigned)((r32 & 15) << 4);
                const unsigned ra = sb + KR_OFF + r32 * 128, rx = (unsigned)((r32 >> 1) & 7);
                kf0[0] = *(const LAS bf16x8*)(ka + ((unsigned)(hi * 16) ^ kx)); kf1[0] = *(const LAS bf16x8*)(ka + 32 * 256 + ((unsigned)(hi * 16) ^ kx));
#pragma unroll
                for (int d0 = 0; d0 < ND; ++d0) {
                    if (d0 + 1 < 8) { const unsigned cb = (unsigned)(((d0 + 1) * 16 + hi * 8) * 2) ^ kx; kf0[(d0 + 1) & 1] = *(const LAS bf16x8*)(ka + cb); kf1[(d0 + 1) & 1] = *(const LAS bf16x8*)(ka + 32 * 256 + cb); }
                    else if (d0 + 1 < ND) { const unsigned ch = ((unsigned)((d0 + 1 - 8) * 2 + hi) ^ rx) << 4; kf0[(d0 + 1) & 1] = *(const LAS bf16x8*)(ra + ch); kf1[(d0 + 1) & 1] = *(const LAS bf16x8*)(ra + 32 * 128 + ch); }
                    p0 = __builtin_amdgcn_mfma_f32_32x32x16_bf16(kf0[d0 & 1], qr[d0], p0, 0, 0, 0);
                    p1 = __builtin_amdgcn_mfma_f32_32x32x16_bf16(kf1[d0 & 1], qr[d0], p1, 0, 0, 0);
                }
            }
            float mn, alpha;
            if (NA) {
                if (j < n1) {
                    const LAS float* brow = bias_l + dr * 31 - qc + 15;
#pragma unroll
                    for (int r = 0; r < 16; ++r) { const int kc = crow(r, hi); const bool v0 = (unsigned)(kc - cs0) < 16u, v1 = (unsigned)(kc + 32 - cs0) < 16u;
                        const float b0 = brow[v0 ? kc : qc], b1 = brow[v1 ? kc + 32 : qc];
                        p0[r] = v0 ? fmaf(p0[r], scale, b0) : -1e30f; p1[r] = v1 ? fmaf(p1[r], scale, b1) : -1e30f; }
                } else {
#pragma unroll
                    for (int r = 0; r < 16; ++r) { p0[r] *= scale; p1[r] *= scale; }
                }
                partialSM(p0, p1, m_reg, mn, alpha, 1.4426950408889634f, THR);
            } else {
                partialSM(p0, p1, m_reg, mn, alpha, scale * 1.4426950408889634f, THR / scale);
            }
            if (__any(alpha < 1.f)) { if (hi == 0) al_l[r32] = alpha; asm volatile("s_waitcnt lgkmcnt(0)" ::: "memory");
#pragma unroll
                for (int r = 0; r < 16; ++r) { const float a = al_l[crow(r, hi)];
#pragma unroll
                    for (int d = 0; d < 4; ++d) o[d][r] *= a; } }
            bf16x8 pa0, pa1, pa2, pa3;
            finishSM(p0, p1, alpha, l_reg, pa0, pa1, pa2, pa3);
            const unsigned vb = sb + V_OFF + v_rd_base(lane);
            pv_one<0>(o[0], vb, pa0, pa1, pa2, pa3); pv_one<1>(o[1], vb, pa0, pa1, pa2, pa3); pv_one<2>(o[2], vb, pa0, pa1, pa2, pa3); pv_one<3>(o[3], vb, pa0, pa1, pa2, pa3);
        }
        slot = (slot == 2) ? 0 : slot + 1; slot2 = (slot2 == 2) ? 0 : slot2 + 1;
    }
    }
    if (hi == 0) li_l[r32] = l_reg; asm volatile("s_waitcnt lgkmcnt(0)" ::: "memory");
    LAS unsigned char* ost = lds + OST_OFF + wid * 2048;
    bf16_t* Ow = Op + (size_t)(wid * 32) * ldo;
#pragma unroll
    for (int g = 0; g < 4; ++g) {
#pragma unroll
        for (int rr = 0; rr < 4; ++rr) { const int r = 4 * g + rr; const int orow = crow(r, hi); const float rl = __builtin_amdgcn_rcpf(li_l[orow]);
#pragma unroll
            for (int d0 = 0; d0 < 4; ++d0) *(LAS bf16_t*)(ost + ((orow & 7) * 128 + d0 * 32 + r32) * 2) = (bf16_t)f2bf(o[d0][r] * rl); }
        asm volatile("s_waitcnt lgkmcnt(0)" ::: "memory");
#pragma unroll
        for (int h = 0; h < 2; ++h) { const int ch = lane + 64 * h; const u32x4 v = *(const LAS u32x4*)(ost + ch * 16);
            *(u32x4*)(Ow + (size_t)(8 * g + (ch >> 4)) * ldo + (ch & 15) * 8) = v;
            float sq = 0.f;
#pragma unroll
            for (int i = 0; i < 4; ++i) { const float x0 = bf2f(v[i] & 0xffffu), x1 = bf2f(v[i] >> 16); sq += x0 * x0 + x1 * x1; }
            sq += shfl_xor_f(sq, 1, lane); sq += shfl_xor_f(sq, 2, lane); sq += shfl_xor_f(sq, 4, lane); sq += shfl_xor_f(sq, 8, lane);
            if ((ch & 15) == 0) ssa[(size_t)(wid * 32 + 8 * g + (ch >> 4)) * 16] = sq; }
        asm volatile("s_waitcnt lgkmcnt(0)" ::: "memory");
    }
#undef ATT_TROW
#undef ATT_ISSUE
}
}

#define XB_TMO      128
#define XB_XCNT(j)  (256  + 64 * (j))
#define XB_XSUB(j)  (1280 + 64 * (j))
#define XB_XGEN(j)  (2304 + 64 * (j))
#define XB_TOP      3328
#define XB_TOPGEN   3392
#define XCD_BAR_WORDS 3456
#define XB_SPIN_CAP (1u << 18)
__device__ __forceinline__ unsigned xb_ld(unsigned* p)              { return __hip_atomic_load(p, __ATOMIC_RELAXED, __HIP_MEMORY_SCOPE_AGENT); }
__device__ __forceinline__ unsigned xb_add(unsigned* p, unsigned v) { return __hip_atomic_fetch_add(p, v, __ATOMIC_RELAXED, __HIP_MEMORY_SCOPE_AGENT); }
__device__ __forceinline__ unsigned xb_xcc_id() { return (unsigned)__builtin_amdgcn_s_getreg((3 << 11) | 20) & 0xFu; }
#define XB_SPIN(cond, bar) do { unsigned _sp = 0; while (cond) { __builtin_amdgcn_s_sleep(1); \
    if ((++_sp & 255u) == 0u) { if (xb_ld(&(bar)[XB_TMO])) break; if (_sp > XB_SPIN_CAP) { atomicAdd(&(bar)[XB_TMO], 1u); break; } } } } while (0)
struct XcdBarrier { unsigned* bar; unsigned x; volatile LAS unsigned* st; int wave; };
__device__ __forceinline__ XcdBarrier xcd_barrier_post(unsigned* bar, volatile LAS unsigned* st) {
    XcdBarrier b; b.bar = bar; b.x = xb_xcc_id(); b.st = st; b.wave = 0;
    if (threadIdx.x == 0) (void)xb_add(&bar[XB_XCNT(b.x)], 1u);
    return b;
}
__device__ __forceinline__ void xcd_barrier_complete(unsigned* bar, unsigned x, unsigned& nloc, unsigned& nx) {
    const unsigned G = gridDim.x * gridDim.y * gridDim.z;
    unsigned sum, cnt, mine, sp = 0u;
    for (;;) {
        sum = 0u; cnt = 0u; mine = 0u;
#pragma unroll
        for (unsigned j = 0; j < 16; ++j) { const unsigned c = xb_ld(&bar[XB_XCNT(j)]); sum += c; cnt += (c > 0u) ? 1u : 0u; mine = (j == x) ? c : mine; }
        if (sum == G) break;
        __builtin_amdgcn_s_sleep(1);
        if ((++sp & 255u) == 0u) { if (xb_ld(&bar[XB_TMO])) break; if (sp > XB_SPIN_CAP) { atomicAdd(&bar[XB_TMO], 1u); break; } }
    }
    nloc = mine > 0u ? mine : 1u; nx = cnt > 0u ? cnt : 1u;
}
__device__ __forceinline__ void xcd_barrier(const XcdBarrier& b) {
    asm volatile("s_waitcnt vmcnt(0)" ::: "memory");
    __syncthreads();
    if (b.wave == 0 && lane_now() == 0) {
        unsigned* bar = b.bar; unsigned bx_ = b.x; asm volatile("" : "+s"(bar), "+s"(bx_));
        __builtin_amdgcn_s_waitcnt(0);
        unsigned nloc = b.st[0], nx = b.st[1];
        if (nloc == 0u) { xcd_barrier_complete(bar, bx_, nloc, nx); b.st[0] = nloc; b.st[1] = nx; }
        const unsigned old = xb_add(&bar[XB_XSUB(bx_)], 1u);
        const unsigned gen = old / nloc;
        if (old + 1u == (gen + 1u) * nloc) {
            __builtin_amdgcn_fence(__ATOMIC_RELEASE, "agent");
            asm volatile("s_waitcnt vmcnt(0)" ::: "memory");
            const unsigned og = xb_add(&bar[XB_TOP], 1u);
            const unsigned tg = og / nx;
            if (og + 1u == (tg + 1u) * nx) xb_add(&bar[XB_TOPGEN], 1u);
            else XB_SPIN(xb_ld(&bar[XB_TOPGEN]) == tg, bar);
            __builtin_amdgcn_fence(__ATOMIC_ACQUIRE, "agent");
            xb_add(&bar[XB_XGEN(bx_)], 1u);
            asm volatile("s_waitcnt vmcnt(0)" ::: "memory");
        } else {
            XB_SPIN(xb_ld(&bar[XB_XGEN(bx_)]) == gen, bar);
            __builtin_amdgcn_fence(__ATOMIC_ACQUIRE, "agent");
            asm volatile("s_waitcnt vmcnt(0)" ::: "memory");
        }
    }
    __syncthreads();
}

struct Args { const float* in[24]; float* out; unsigned char* ws; int ph_lo, ph_hi; };
enum { I_X = 0, I_C, I_CTX, I_CCTX, I_ADAW, I_ADAB, I_F1N, I_F1W1, I_F1W3, I_F1W2, I_MIXN, I_WIN, I_QAN, I_WUQ, I_KVAN, I_WUKV, I_RPB, I_OUTN, I_WOUT, I_F2N, I_F2W1, I_F2W3, I_F2W2, I_FINN };
struct Frame {
    LAS unsigned char* lds; int wave, vcu, G, bx;
    float* out; unsigned char* ws; const float* x; const float* ctx;
};
__device__ __forceinline__ unsigned char* wl(const Frame& F, int  , size_t off) { return F.ws + WS_W + off; }
__device__ __forceinline__ float* fMOD(const Frame& F) { return (float*)(F.ws + WS_MOD); }
__device__ __forceinline__ bf16_t* fXN(const Frame& F) { return (bf16_t*)(F.ws + WS_XN); }
__device__ __forceinline__ unsigned char* fBIG(const Frame& F) { return F.ws + WS_BIG; }
__device__ __forceinline__ const float* fSM(const Frame& F, int off) { return (const float*)(F.ws + WS_SMALL) + off; }

__device__ __forceinline__ void tr_item(const float* __restrict__ W, int ldw, int k0, int srccol0, bool ropeperm, const float* __restrict__ gain, bool zero,
                                        bf16_t* __restrict__ WT, int ldt, int dstrow0, LAS float* scr, int lane) {
    if (!zero) {
        float v[32];
        const float* wp = W + (size_t)(k0 + (lane >> 5)) * ldw + srccol0 + (lane & 31);
#pragma unroll
        for (int i = 0; i < 32; ++i) v[i] = wp[(size_t)(2 * i) * ldw];
#pragma unroll
        for (int i = 0; i < 32; ++i) scr[(2 * i + (lane >> 5)) * 33 + (lane & 31)] = v[i];
    }
    LDS_WAIT(); asm volatile("" ::: "memory");
    const int c = lane & 7;
    float gk[8];
#pragma unroll
    for (int q = 0; q < 8; ++q) gk[q] = gain ? gain[k0 + 8 * c + q] : 1.0f;
#pragma unroll
    for (int j = 0; j < 4; ++j) { const int n = (lane >> 3) + 8 * j; const int sn = ropeperm ? (((n >> 2) & 1) * 16 + (n >> 3) * 4 + (n & 3)) : n;
        const LAS float* s = scr + (8 * c) * 33 + sn;
        u32x4 o;
        if (zero) { unsigned z_ = 0u; asm volatile("" : "+v"(z_)); o = (u32x4){z_, z_, z_, z_}; }
        else { o.x = cvt_pk_bf16(s[0 * 33] * gk[0], s[1 * 33] * gk[1]); o.y = cvt_pk_bf16(s[2 * 33] * gk[2], s[3 * 33] * gk[3]); o.z = cvt_pk_bf16(s[4 * 33] * gk[4], s[5 * 33] * gk[5]); o.w = cvt_pk_bf16(s[6 * 33] * gk[6], s[7 * 33] * gk[7]); }
        *(u32x4*)(WT + (size_t)(dstrow0 + n) * ldt + k0 + 8 * c) = o; }
    LDS_WAIT(); asm volatile("" ::: "memory");
}
__device__ __forceinline__ void convert_range(Frame& F, const float* const* in, const int l, const int it_lo, const int it_hi, const int gw, const int NGW);
__device__ __forceinline__ void p0_prologue(Frame& F, const float* const* in) {
    const int tid_ = opaque_tid(F.wave), lane_ = tid_ & 63; (void)tid_; (void)lane_;
    {
        LAS float* SC = (LAS float*)F.lds;
        for (int i = tid_; i < 17 * D; i += 512) { const int r = i >> 11, k = i & (D - 1); const float v = (r < 16) ? in[I_C][r * D + k] : in[I_CCTX][k]; SC[i] = silu_f(v); }
        __syncthreads();
        for (int item = F.bx; item < 256; item += F.G) {
            const int l = item >> 7, n0 = (item & 127) * 144;
            const float* W = in[I_ADAW] + (size_t)l * D * NMOD + n0 + 4 * lane_;
            f32x4 acc[17];
#pragma unroll
            for (int r = 0; r < 17; ++r) acc[r] = (f32x4){0.f, 0.f, 0.f, 0.f};
            const int kb = F.wave * 256;
            if (lane_ < 36) {
                for (int kk = 0; kk < 256; kk += 8) {
                    f32x4 w[8];
#pragma unroll
                    for (int q = 0; q < 8; ++q) w[q] = *(const f32x4*)(W + (size_t)(kb + kk + q) * NMOD);
#pragma unroll
                    for (int r = 0; r < 17; ++r) { const f32x4 s = *(const LAS f32x4*)(SC + r * D + kb + kk), s2 = *(const LAS f32x4*)(SC + r * D + kb + kk + 4);
                        acc[r] += w[0] * s[0]; acc[r] += w[1] * s[1]; acc[r] += w[2] * s[2]; acc[r] += w[3] * s[3];
                        acc[r] += w[4] * s2[0]; acc[r] += w[5] * s2[1]; acc[r] += w[6] * s2[2]; acc[r] += w[7] * s2[3]; }
                }
            }
            __syncthreads();
            LAS float* PT = (LAS float*)F.lds;
            LAS float* PT2 = (LAS float*)(F.lds + 0);
            (void)PT2;
            if (lane_ < 36) {
#pragma unroll
                for (int r = 0; r < 17; ++r) *(LAS f32x4*)(PT + (F.wave * 17 + r) * 144 + 4 * lane_) = acc[r];
            }
            __syncthreads();
            for (int i = tid_; i < 17 * 144; i += 512) { const int r = i / 144, cidx = i % 144; float s = in[I_ADAB][l * NMOD + n0 + cidx];
#pragma unroll
                for (int w = 0; w < 8; ++w) s += PT[(w * 17 + r) * 144 + cidx];
                fMOD(F)[((size_t)l * 17 + r) * NMOD + n0 + cidx] = s; }
            __syncthreads();
            if (item + F.G < 256) {
                for (int i = tid_; i < 17 * D; i += 512) { const int r = i >> 11, k = i & (D - 1); const float v = (r < 16) ? in[I_C][r * D + k] : in[I_CCTX][k]; SC[i] = silu_f(v); }
                __syncthreads();
            }
        }
    }
    if (F.bx == 0) {
        float* cosT = (float*)(F.ws + WS_ROPE); float* sinT = cosT + 1024;
        for (int i = tid_; i < 1024; i += 512) { const int pos = i >> 4, f = i & 15; const float inv = powf(10000.f, -(float)f / 16.f); const float ang = (float)pos * inv; cosT[i] = cosf(ang); sinT[i] = sinf(ang); }
    }
    { float* sm = (float*)(F.ws + WS_SMALL);
      for (int i = F.bx * 512 + tid_; i < SM_TOTAL; i += F.G * 512) { float v;
          if (i < SM_MIXN) v = in[I_F1N][i]; else if (i < SM_F2N) v = in[I_MIXN][i - SM_MIXN]; else if (i < SM_OUTN) v = in[I_F2N][i - SM_F2N]; else if (i < SM_FINN) v = in[I_OUTN][i - SM_OUTN];
          else if (i < SM_RPB) v = in[I_FINN][i - SM_FINN]; else v = in[I_RPB][i - SM_RPB];
          sm[i] = v; } }
    __syncthreads();
    convert_range(F, in, 0, 0, CV_ALL, F.vcu * 8 + F.wave, F.G * 8);
}
__device__ __forceinline__ void convert_range(Frame& F, const float* const* in, const int l, const int it_lo, const int it_hi, const int gw, const int NGW) {
    const int tid_ = opaque_tid(F.wave), lane_ = tid_ & 63; (void)tid_;
    __syncthreads();
    LAS float* scr = (LAS float*)(F.lds + F.wave * 16384);
    constexpr int I_13 = CV_I13, I_2 = CV_I2, I_IN = CV_IIN, I_UP = CV_IUP;
    for (int it = it_lo + gw; it < it_hi; it += NGW) {
        int r = it;
        bool done = false;
#pragma unroll
        for (int f = 0; f < 2; ++f) {
            if (!done && r < I_13) {
                const int nblk = 2 * DFF / 32, kb = r / nblk, nb = r % nblk, n0 = nb * 32, pn = n0 >> 8, j = n0 & 255;
                const float* W = (j < 128) ? in[f ? I_F2W1 : I_F1W1] : in[f ? I_F2W3 : I_F1W3];
                tr_item(W + (size_t)l * D * DFF, DFF, kb * 64, pn * 128 + (j & 127), false, nullptr, false, (bf16_t*)wl(F, l, f ? WL_W13B : WL_W13A), D, n0, scr, lane_); done = true; }
            if (!done) r -= I_13;
            if (!done && r < I_2) {
                const int nblk = D / 32, kb = r / nblk, nb = r % nblk;
                tr_item(in[f ? I_F2W2 : I_F1W2] + (size_t)l * DFF * D, D, kb * 64, nb * 32, false, nullptr, false, (bf16_t*)wl(F, l, f ? WL_W2B : WL_W2A), DFF, nb * 32, scr, lane_); done = true; }
            if (!done) r -= I_2;
        }
        if (done) continue;
        if (r < I_IN) {
            const int nblk = PINP / 32, kb = r / nblk, nb = r % nblk, n0 = nb * 32;
            const int src = (n0 < 1024) ? n0 : (n0 < 4096) ? n0 + 64 : (n0 < PIN) ? 1024 + (n0 - 4096) : 0;
            tr_item(in[I_WIN] + (size_t)l * D * PIN, PIN, kb * 64, src, n0 >= 4096 && n0 < PIN  , nullptr, n0 >= PIN, (bf16_t*)wl(F, l, WL_WIN), D, n0, scr, lane_); continue; }
        r -= I_IN;
        if (r < I_UP) {
            const int nblk = UPW / 32, kb = r / nblk, nb = r % nblk, n0 = nb * 32;
            if (n0 < QW) { const int within = n0 % 192;
                tr_item(in[I_WUQ] + (size_t)l * 512 * QW, QW, kb * 64, n0, within >= 128, in[I_QAN] + l * 512, false, (bf16_t*)wl(F, l, WL_WUP), 512, n0, scr, lane_); }
            else tr_item(in[I_WUKV] + (size_t)l * 512 * KVW, KVW, kb * 64, n0 - QW, false, in[I_KVAN] + l * 512, false, (bf16_t*)wl(F, l, WL_WUP), 512, n0, scr, lane_);
            continue; }
        r -= I_UP;
        { const int nblk = D / 32, kb = r / nblk, nb = r % nblk;
          tr_item(in[I_WOUT] + (size_t)l * D * D, D, kb * 64, nb * 32, false, in[I_OUTN] + l * D  , false, (bf16_t*)wl(F, l, WL_WOUT), D, nb * 32, scr, lane_); }
    }
}

__device__ __forceinline__ void cvec_layer(Frame& F, const int l);
__device__ __forceinline__ void init_phase(Frame& F) {
    const int tid_ = opaque_tid(F.wave), lane_ = tid_ & 63; (void)tid_;
    const int gw = F.vcu * 8 + F.wave, NGW = F.G * 8;
    {
        const float* gain = fSM(F, SM_F1N); float* SS = (float*)(F.ws + WS_SS);
        for (int it = gw; it < MT / 4; it += NGW) {
            const int row0 = it * 4; const int b = row0 < ML ? (row0 >> 11) : 16;
            const float* mod = fMOD(F) + (size_t)b * NMOD;
            f32x4 gs[4][2];
#pragma unroll
            for (int j = 0; j < 4; ++j)
#pragma unroll
                for (int h = 0; h < 2; ++h) { const int c = 8 * lane_ + 512 * j + 4 * h; gs[j][h] = *(const f32x4*)(gain + c) * (*(const f32x4*)(mod + 1 * D + c) + 1.0f); }
#pragma unroll 2
            for (int rr = 0; rr < 4; ++rr) { const int row = row0 + rr;
                const float* hp = (row < ML) ? F.x + (size_t)row * D : F.ctx + (size_t)(row - ML) * D;
                f32x4 v[4][2]; float ss = 0.f;
#pragma unroll
                for (int j = 0; j < 4; ++j)
#pragma unroll
                    for (int h = 0; h < 2; ++h) { v[j][h] = *(const f32x4*)(hp + 8 * lane_ + 512 * j + 4 * h); const f32x4 x = v[j][h]; ss += (x[0] * x[0] + x[1] * x[1]) + (x[2] * x[2] + x[3] * x[3]); }
                ss = wave_sum(ss, lane_);
                if (lane_ < 8) SS[(size_t)row * 8 + lane_] = (lane_ == 0) ? ss : 0.f;
                bf16_t* op = fXN(F) + (size_t)row * XNP + 8 * lane_;
                _Float16* hp16 = (_Float16*)(F.ws + WS_H16) + (size_t)row * D + 8 * lane_;
#pragma unroll
                for (int j = 0; j < 4; ++j) { u32x4 hv; hv.x = cvt_pk_f16(v[j][0][0], v[j][0][1]); hv.y = cvt_pk_f16(v[j][0][2], v[j][0][3]); hv.z = cvt_pk_f16(v[j][1][0], v[j][1][1]); hv.w = cvt_pk_f16(v[j][1][2], v[j][1][3]);
                    *(u32x4*)(hp16 + 512 * j) = hv; }
#pragma unroll
                for (int j = 0; j < 4; ++j) { const f32x4 a = v[j][0] * gs[j][0], c = v[j][1] * gs[j][1];
                    u32x4 w; w.x = cvt_pk_bf16(a[0], a[1]); w.y = cvt_pk_bf16(a[2], a[3]); w.z = cvt_pk_bf16(c[0], c[1]); w.w = cvt_pk_bf16(c[2], c[3]);
                    *(u32x4*)(op + 512 * j) = w; }
            }
        }
    }
    cvec_layer(F, 0);
}
__device__ __forceinline__ void cvec_layer(Frame& F, const int l) {
    const int tid_ = opaque_tid(F.wave), lane_ = tid_ & 63;
    const int gw = F.vcu * 8 + F.wave, NGW = F.G * 8;
    constexpr int PITCH = D + 8;
    LAS bf16_t* SHH = (LAS bf16_t*)F.lds; LAS bf16_t* SHL = SHH + 17 * PITCH;
    static_assert(2 * 17 * PITCH * 2 <= LDSCTL_OFF, "cvec_layer LDS");
    int sp, lw, nw;
    { const int w = (F.vcu * 256) / F.G;
      if (w < 108) { sp = 0; lw = w; nw = 108; } else if (w < 148) { sp = 1; lw = w - 108; nw = 40; } else { sp = 2; lw = w - 148; nw = 108; } }
    const bool fullgrid = (F.G == 256);
    for (int pass = 0; pass < (fullgrid ? 1 : 3); ++pass) {
        const int s = fullgrid ? sp : pass;
        const int N = (s == 1) ? PINP : 2 * DFF; const int sidx = 3 * s;
        const bf16_t* Wt = (const bf16_t*)wl(F, l, s == 0 ? WL_W13A : s == 1 ? WL_WIN : WL_W13B);
        float* out = (float*)(F.ws + WS_CB) + (size_t)l * CB_LAYER + (s == 0 ? CB_S0 : s == 1 ? CB_S1 : CB_S2);
        __syncthreads();
        for (int i = tid_; i < 17 * D; i += 512) { const int b = i >> 11, k = i & (D - 1); const float v = fMOD(F)[((size_t)l * 17 + b) * NMOD + sidx * D + k];
            const unsigned hb = f2bf(v); const float lo = v - bf2f(hb); SHH[b * PITCH + k] = (bf16_t)hb; SHL[b * PITCH + k] = (bf16_t)f2bf(lo); }
        __syncthreads();
        const int r32 = lane_ & 31, hi = lane_ >> 5, brow = r32 < 16 ? r32 : 16;
        const int gwl = fullgrid ? lw * 8 + F.wave : gw, ngwl = fullgrid ? nw * 8 : NGW;
        for (int blk = gwl; blk < N / 32; blk += ngwl) {
            const bf16_t* wp = Wt + (size_t)(blk * 32 + r32) * D + hi * 8;
            const LAS bf16_t* ah = SHH + brow * PITCH + hi * 8; const LAS bf16_t* al = SHL + brow * PITCH + hi * 8;
            f32x16 acc;
#pragma unroll
            for (int r = 0; r < 16; ++r) acc[r] = 0.f;
            for (int k0 = 0; k0 < D; k0 += 128) {
                bf16x8 bw[8];
#pragma unroll
                for (int q = 0; q < 8; ++q) bw[q] = *(const bf16x8*)(wp + k0 + 16 * q);
#pragma unroll
                for (int q = 0; q < 8; ++q) { const bf16x8 a0 = *(const LAS bf16x8*)(ah + k0 + 16 * q), a1 = *(const LAS bf16x8*)(al + k0 + 16 * q);
                    acc = __builtin_amdgcn_mfma_f32_32x32x16_bf16(a0, bw[q], acc, 0, 0, 0);
                    acc = __builtin_amdgcn_mfma_f32_32x32x16_bf16(a1, bw[q], acc, 0, 0, 0); }
            }
#pragma unroll
            for (int r = 0; r < 16; ++r) { const int b = (r & 3) + 8 * (r >> 2) + 4 * hi; if (b < 17) out[(size_t)b * N + blk * 32 + r32] = acc[r]; }
        }
    }
}
__device__ __forceinline__ void final_phase(Frame& F) {
    const int tid_ = opaque_tid(F.wave), lane_ = tid_ & 63; (void)tid_;
    const int gw = F.vcu * 8 + F.wave, NGW = F.G * 8;
    const float* gain = fSM(F, SM_FINN);
    f32x4 g[4][2];
#pragma unroll
    for (int j = 0; j < 4; ++j)
#pragma unroll
        for (int h = 0; h < 2; ++h) g[j][h] = *(const f32x4*)(gain + 8 * lane_ + 512 * j + 4 * h);
    for (int row = gw; row < ML; row += NGW) {
        const _Float16* hp = (const _Float16*)(F.ws + WS_H16) + (size_t)row * D + 8 * lane_;
        float* op = F.out + (size_t)row * D + 8 * lane_;
        f32x4 v[4][2]; float ss = 0.f;
#pragma unroll
        for (int j = 0; j < 4; ++j) { h8_to_f32(*(const u32x4*)(hp + 512 * j), v[j][0], v[j][1]);
#pragma unroll
            for (int h = 0; h < 2; ++h) { const f32x4 x = v[j][h]; ss += (x[0] * x[0] + x[1] * x[1]) + (x[2] * x[2] + x[3] * x[3]); } }
        const float rinv = 1.0f / sqrtf(wave_sum(ss, lane_) * (1.0f / D) + EPS);
#pragma unroll
        for (int j = 0; j < 4; ++j)
#pragma unroll
            for (int h = 0; h < 2; ++h) *(f32x4*)(op + 512 * j + 4 * h) = v[j][h] * rinv * g[j][h];
    }
}

__device__ __forceinline__ void attn_phase(Frame& F, int l, bool ctx_out) {
    const int grp = F.vcu >> 3, k8 = F.vcu & 7;
    const bf16_t* Q = (const bf16_t*)(fBIG(F) + BG_Q); const bf16_t* KV = (const bf16_t*)(fBIG(F) + BG_KV); const bf16_t* KR = (const bf16_t*)(fBIG(F) + BG_KR);
    const bf16_t* NQ = (const bf16_t*)(fBIG(F) + BG_NQKV); const bf16_t* NK = NQ + (size_t)MT * 1024; const bf16_t* NV = NK + (size_t)MT * 1024;
    bf16_t* AO = (bf16_t*)(F.ws + WS_AO); float* SSA = (float*)(fBIG(F) + BG_KRF);
#ifndef ATT_ONLY
#define ATT_ONLY 0
#endif
    const int nmla = (ATT_ONLY == 2) ? 0 : 4 + ((ctx_out && F.vcu < 128) ? 1 : 0);
    for (int i = 0; i < nmla; ++i) {
        int b, h, q0, base1, n1;
        if (i < 4) { const int bh = grp + 32 * i; b = bh >> 3; h = bh & 7; q0 = b * SEQ + k8 * 256; base1 = b * SEQ; n1 = 32; }
        else { const int bh = F.vcu; b = bh >> 3; h = bh & 7; q0 = ML + b * CTXL; base1 = 0; n1 = 0; }
        att::attn_unit<192, false>(F.lds, F.wave, Q + (size_t)q0 * QW + h * 192, QW, KV + h * 256, KV + h * 256 + 128, KVW, KR,
                                   base1, n1, ML + b * CTXL, 4, MLA_SCALE, AO + (size_t)q0 * D + h * 128, D, nullptr, 0, 0, SSA + (size_t)q0 * 16 + h);
    }
    const int nna = (ATT_ONLY == 1) ? 0 : 4 + ((ctx_out && F.vcu >= 128) ? 1 : 0);
    for (int i = 0; i < nna; ++i) {
        int b, h, q0, base1, n1, strip0, qgr0;
        if (i < 4) { const int bh = grp + 32 * i; b = bh >> 3; h = bh & 7; const int rg = (k8 + 2 * i) & 7; qgr0 = 4 * rg; q0 = b * SEQ + rg * 256;
            strip0 = min(max(qgr0 - 4, 0), 24); const int send = min(max(qgr0 + 3 - 4, 0), 24) + 8; n1 = send - strip0; base1 = b * SEQ + strip0 * 64; }
        else { const int bh = F.vcu - 128; b = bh >> 3; h = bh & 7; q0 = ML + b * CTXL; base1 = 0; n1 = 0; strip0 = 0; qgr0 = 0; }
        att::attn_unit<128, true>(F.lds, F.wave, NQ + (size_t)q0 * 1024 + h * 128, 1024, NK + h * 128, NV + h * 128, 1024, nullptr,
                                  base1, n1, ML + b * CTXL, 4, NA_SCALE, AO + (size_t)q0 * D + 1024 + h * 128, D, fSM(F, SM_RPB) + (l * 8 + h) * 465, strip0, qgr0, SSA + (size_t)q0 * 16 + 8 + h);
    }
}

__global__ void __launch_bounds__(512, 2) mk_fwd(Args args) {
    extern __shared__ __attribute__((aligned(16))) unsigned char lds_raw[];
    Frame F;
    F.lds = (LAS unsigned char*)lds_raw;
    const int wave0 = __builtin_amdgcn_readfirstlane((int)threadIdx.x >> 6), G0 = gridDim.x, bx0 = blockIdx.x;
    const int vcu0 = (G0 % 8 == 0) ? (bx0 % 8) * (G0 / 8) + bx0 / 8 : bx0;
    F.wave = wave0; F.G = G0; F.vcu = vcu0; F.bx = bx0;
    F.out = args.out; F.ws = args.ws; F.x = args.in[I_X]; F.ctx = args.in[I_CTX];
    volatile LAS unsigned* MISC = (volatile LAS unsigned*)(F.lds + MISC_OFF);
    for (int u = threadIdx.x; u < (LDS_BYTES - LDSCTL_OFF) / 4; u += 512) ((LAS unsigned*)(F.lds + LDSCTL_OFF))[u] = 0u;
    __syncthreads();
    unsigned* ctl = (unsigned*)(args.ws + WS_CTL);
    XcdBarrier bar; bar.bar = ctl + CW_BAR; bar.x = 0; bar.st = nullptr; bar.wave = 0;
    const int lo = args.ph_lo, hi = args.ph_hi;
    const bool use_bar = (hi - lo) > 1;
    if (use_bar) bar = xcd_barrier_post(ctl + CW_BAR, MISC + 8);
    bar.wave = wave0;
#ifndef MK_ONLY
#define MK_ONLY -1
#endif
#define TY(t) (MK_ONLY < 0 || MK_ONLY == (t))
#ifndef MK_REP_TYPE
#define MK_REP_TYPE -1
#endif
#ifndef MK_REP_N
#define MK_REP_N 1
#endif
#define NREP(t) ((MK_REP_TYPE == (t)) ? MK_REP_N : 1)
#define REPEAT(t) for (int rp_ = 0; rp_ < NREP(t); ++rp_)
#define REPBAR() do { if (rp_ > 0) xcd_barrier(bar); } while (0)
#ifndef MK_CVLATE
#define MK_CVLATE 1
#endif
#ifndef MK_FUSEFIN
#define MK_FUSEFIN 1
#endif
#ifndef MK_SPK
#define MK_SPK 1
#endif
#ifndef MK_WGM_SWI
#define MK_WGM_SWI 4
#endif
#ifndef MK_WGM_DOWN
#define MK_WGM_DOWN 4
#endif
#ifndef MK_WGM_WIN
#define MK_WGM_WIN 4
#endif
#ifndef MK_WGM_UP
#define MK_WGM_UP 4
#endif
#ifndef MK_WGM_WOUT
#define MK_WGM_WOUT 4
#endif
#ifndef MK_REP_NULL
#define MK_REP_NULL 0
#endif
#define IN(k) (lo <= (k) && (k) < hi)
#define SEAM(k) do { if (IN(k) && IN((k) + 1)) xcd_barrier(bar); } while (0)
#define FRESH() do { unsigned char* w_ = args.ws; float* o_ = args.out; int wv_ = wave0, vc_ = vcu0, g_ = G0, bx_ = bx0; asm volatile("" : "+s"(w_), "+s"(o_), "+s"(wv_), "+s"(vc_), "+s"(g_), "+s"(bx_)); F.ws = w_; F.out = o_; F.wave = wv_; F.vcu = vc_; F.G = g_; F.bx = bx_; } while (0)
    LAS unsigned char* ring = F.lds;

    if (TY(0) && IN(0)) REPEAT(0) { REPBAR(); FRESH(); p0_prologue(F, args.in); } SEAM(0);
    if (TY(1) && IN(1)) REPEAT(1) { REPBAR(); FRESH(); init_phase(F); } SEAM(1);

#pragma unroll 1
    for (int l = 0; l < DEPTH; ++l) {
        const int pb = 2 + 9 * l; const bool last = (l == DEPTH - 1);
        const bool tailcv = (!last) && (F.G == 256);
        const bool fusefin = MK_FUSEFIN && (F.G == 256) && (MK_REP_TYPE < 0);
        if (l > 0) {
            if (TY(0) && IN(pb - 1)) { FRESH(); if (F.G == 256) { if (!MK_CVLATE) { convert_range(F, args.in, l, CV_W2B, CV_WIN, F.vcu * 8 + F.wave, F.G * 8); convert_range(F, args.in, l, CV_WOUT, CV_ALL, F.vcu * 8 + F.wave, F.G * 8); } }
                else convert_range(F, args.in, l, 0, CV_ALL, F.vcu * 8 + F.wave, F.G * 8);
                __syncthreads(); cvec_layer(F, l); }
            SEAM(pb - 1);
        }
#define TAILCV_AT(thr_, lo_, hi_) do { if (tailcv && F.bx >= (thr_)) convert_range(F, args.in, l + 1, (lo_), (hi_), (F.bx - (thr_)) * 8 + F.wave, (256 - (thr_)) * 8); } while (0)
#define TAILCV_IDLE(lo_, hi_) do { if (tailcv && F.bx >= 128) convert_range(F, args.in, l + 1, (lo_), (hi_), (F.bx - 128) * 8 + F.wave, 1024); } while (0)
#define TAILCV_SPLIT(lo_, hi_) do { if (tailcv) { const int off_ = F.bx >> 3, j_ = ((off_ >> 1) * 8 + (F.bx & 7)) * 8 + F.wave; \
        if (off_ & 1) { convert_range(F, args.in, l + 1, (lo_), (hi_), j_, 3072); convert_range(F, args.in, l + 1, (lo_), (hi_), 1024 + j_, 3072); } else convert_range(F, args.in, l + 1, (lo_), (hi_), 2048 + j_, 3072); } } while (0)
#define SPKSET(ph_) do { if (F.G == 256 && rp_ == 0) { S.spk = F.ws; S.epoch = (ph_) + 1; } } while (0)
#if MK_SPK & 1
#define TAILCV_D TAILCV_SPLIT
#else
#define TAILCV_D TAILCV_IDLE
#endif
#if MK_SPK & 2
#define TAILCV_O TAILCV_SPLIT
#else
#define TAILCV_O TAILCV_IDLE
#endif
#define MODL (fMOD(F) + (size_t)l * 17 * NMOD)
#define SSP ((float*)(F.ws + WS_SS))
#define CBP(s_) ((const float*)(F.ws + WS_CB) + (size_t)l * CB_LAYER + (s_))
        const int Mlate = last ? ML : MT;
        if (TY(2) && IN(pb + 0)) REPEAT(2) { REPBAR(); FRESH(); pg8::Gemm g{fXN(F), (const bf16_t*)wl(F, l, WL_W13A), XNP, D, D}; pg8::Order S; S.init(MT / 256, 2 * DFF / 256, F.G, F.bx, MK_WGM_SWI);
            pg8::EpiSwiGLU E{(bf16_t*)(fBIG(F) + BG_G), DFF, SSP, CBP(CB_S0)}; if (MK_REP_NULL && rp_) { pg8::EpiNull<true> EN; pg8::gemm_phase<pg8::EpiNull<true>, true, true>(ring, F.wave, g, S, EN); } else pg8::gemm_phase<pg8::EpiSwiGLU, true, true>(ring, F.wave, g, S, E); }
        SEAM(pb + 0);
        if (TY(3) && IN(pb + 1)) REPEAT(3) { REPBAR(); FRESH(); pg8::Gemm g{(const bf16_t*)(fBIG(F) + BG_G), (const bf16_t*)wl(F, l, WL_W2A), DFF, DFF, DFF}; pg8::Order S; S.init(MT / 256, D / 256, F.G, F.bx, MK_WGM_DOWN); if (MK_SPK & 1) SPKSET(pb + 1);
            pg8::EpiResid<false> E{F.ws, F.out, l, 2, rp_ ? 0.0f : 0.5f, 1, SM_MIXN + l * D, l, 4, 0};
            if (MK_REP_NULL && rp_) { pg8::EpiNull<true> EN; pg8::gemm_phase<pg8::EpiNull<true>, true, true>(ring, F.wave, g, S, EN); } else pg8::gemm_phase<pg8::EpiResid<false>, true, true, (MK_SPK & 1) != 0>(ring, F.wave, g, S, E);
            if (!(MK_SPK & 1)) TAILCV_IDLE(CV_W13A, CV_W2A); }
        SEAM(pb + 1);
        if (TY(4) && IN(pb + 2)) REPEAT(4) { REPBAR(); FRESH(); pg8::Gemm g{fXN(F), (const bf16_t*)wl(F, l, WL_WIN), XNP, D, D}; pg8::Order S; S.init(MT / 256, PINP / 256, F.G, F.bx, MK_WGM_WIN);
            pg8::EpiWin E{(bf16_t*)(fBIG(F) + BG_CQKV), (bf16_t*)(fBIG(F) + BG_NQKV), (bf16_t*)(fBIG(F) + BG_KR), (float*)(F.ws + WS_RINV), SSP, CBP(CB_S1), (const float*)(F.ws + WS_ROPE)}; pg8::gemm_phase<pg8::EpiWin, true, true>(ring, F.wave, g, S, E);
            if (MK_SPK & 1) TAILCV_AT(144, CV_W13A, CV_W2A);
            if (MK_CVLATE && last && F.G == 256 && F.bx >= 144 && rp_ == 0) convert_range(F, args.in, l, CV_W2B, CV_WIN, (F.bx - 144) * 8 + F.wave, 112 * 8); }
        SEAM(pb + 2);
        if (TY(6) && IN(pb + 3)) REPEAT(6) { REPBAR(); FRESH(); pg8::Gemm g{(const bf16_t*)(fBIG(F) + BG_CQKV), (const bf16_t*)wl(F, l, WL_WUP), 1024, 512, 512}; pg8::Order S; S.init(MT / 256, UPW / 256, F.G, F.bx, MK_WGM_UP, 6, 512);
            const float* cosT = (const float*)(F.ws + WS_ROPE);
            pg8::EpiUp E{(bf16_t*)(fBIG(F) + BG_Q), (bf16_t*)(fBIG(F) + BG_KV), (const float*)(F.ws + WS_RINV), cosT, cosT + 1024}; pg8::gemm_phase<pg8::EpiUp, true, true>(ring, F.wave, g, S, E); }
        SEAM(pb + 3);
        if (TY(7) && IN(pb + 4)) REPEAT(7) { REPBAR(); FRESH(); attn_phase(F, l, !last); }
        SEAM(pb + 4);
        if (TY(3) && IN(pb + 5)) REPEAT(10) { REPBAR(); FRESH(); pg8::Gemm g{(const bf16_t*)(F.ws + WS_AO), (const bf16_t*)wl(F, l, WL_WOUT), D, D, D}; pg8::Order S; S.init(Mlate / 256, D / 256, F.G, F.bx, MK_WGM_WOUT); if (MK_SPK & 2) SPKSET(pb + 5);
            pg8::EpiResid<true> E{F.ws, F.out, l, 5, rp_ ? 0.0f : 1.0f, 1, SM_F2N + l * D, l, 7, 0};
            if (MK_REP_NULL && rp_) { pg8::EpiNull<true> EN; pg8::gemm_phase<pg8::EpiNull<true>, true, true>(ring, F.wave, g, S, EN); } else pg8::gemm_phase<pg8::EpiResid<true>, true, true, (MK_SPK & 2) != 0>(ring, F.wave, g, S, E);
            TAILCV_O(CV_W2A, CV_W13B); TAILCV_O(CV_WUP, CV_WOUT); if (MK_SPK & 1) TAILCV_O(CV_WIN, CV_WUP); }
        SEAM(pb + 5);
        if (TY(2) && IN(pb + 6)) REPEAT(2) { REPBAR(); FRESH(); pg8::Gemm g{fXN(F), (const bf16_t*)wl(F, l, WL_W13B), XNP, D, D}; pg8::Order S; S.init(Mlate / 256, 2 * DFF / 256, F.G, F.bx, MK_WGM_SWI);
            pg8::EpiSwiGLU E{(bf16_t*)(fBIG(F) + BG_G), DFF, SSP, CBP(CB_S2)}; if (MK_REP_NULL && rp_) { pg8::EpiNull<true> EN; pg8::gemm_phase<pg8::EpiNull<true>, true, true>(ring, F.wave, g, S, EN); } else pg8::gemm_phase<pg8::EpiSwiGLU, true, true>(ring, F.wave, g, S, E);
            if (MK_CVLATE && rp_ == 0) TAILCV_AT(192, CV_WOUT, CV_ALL); }
        SEAM(pb + 6);
        if (TY(3) && IN(pb + 7)) REPEAT(3) { REPBAR(); FRESH(); pg8::Gemm g{(const bf16_t*)(fBIG(F) + BG_G), (const bf16_t*)wl(F, l, WL_W2B), DFF, DFF, DFF}; pg8::Order S; S.init(Mlate / 256, D / 256, F.G, F.bx, MK_WGM_DOWN); if (MK_SPK & 1) SPKSET(pb + 7);
            const int ln = last ? l : l + 1;
            pg8::EpiResid<false> E{F.ws, F.out, l, 8, (rp_ && !last) ? 0.0f : 0.5f, last ? 0 : 1, SM_F1N + ln * D, ln, 1, (last && fusefin) ? 1 : 0};
            if (MK_REP_NULL && rp_) { pg8::EpiNull<true> EN; pg8::gemm_phase<pg8::EpiNull<true>, true, true>(ring, F.wave, g, S, EN); } else pg8::gemm_phase<pg8::EpiResid<false>, true, true, (MK_SPK & 1) != 0>(ring, F.wave, g, S, E);
            TAILCV_D(CV_W13B, CV_W2B); if (!(MK_SPK & 1)) TAILCV_D(CV_WIN, CV_WUP); }
        if (!(last && fusefin)) SEAM(pb + 7);
    }
    if (TY(9) && IN(NPHASE - 1) && !(MK_FUSEFIN && (F.G == 256) && (MK_REP_TYPE < 0))) { FRESH(); final_phase(F); }
#undef IN
#undef SEAM
}

#if MK_DEBUG
__device__ __forceinline__ double dbf(bf16_t b) { return (double)__builtin_bit_cast(float, ((unsigned)b) << 16); }
__device__ __forceinline__ unsigned hsh(unsigned x) { x ^= x >> 16; x *= 0x7feb352du; x ^= x >> 15; x *= 0x846ca68bu; x ^= x >> 16; return x; }
__device__ __forceinline__ double dsilu(double x) { return x / (1.0 + exp(-x)); }
__device__ __forceinline__ double dh16(const _Float16* p) { return (double)(float)*p; }
struct DbgLoc { const void* p; int isbf; float atol; };
__device__ void dbg_sample(const Args& a, int ph, int s, double& expv, DbgLoc& loc) {
    const unsigned char* ws = a.ws; const float* const* in = a.in;
    const float* MOD = (const float*)(ws + WS_MOD); const _Float16* H16 = (const _Float16*)(ws + WS_H16); const bf16_t* XN = (const bf16_t*)(ws + WS_XN); const unsigned char* BIG = ws + WS_BIG;
    const unsigned h1 = hsh(s * 2654435761u + ph * 97u + 1u), h2 = hsh(h1 + 0x9e3779b9u), h3 = hsh(h2 + 77u);
    loc.atol = 0.02f; loc.isbf = 1; loc.p = nullptr; expv = 0.0;
    if (ph == 0) { const int l = h1 & 1, r = h2 % 17, n = h3 % NMOD; double acc = in[I_ADAB][l * NMOD + n];
        for (int k = 0; k < D; ++k) { const double c = (r < 16) ? in[I_C][r * D + k] : in[I_CCTX][k]; acc += dsilu(c) * (double)in[I_ADAW][((size_t)l * D + k) * NMOD + n]; }
        expv = acc; loc.p = MOD + ((size_t)l * 17 + r) * NMOD + n; loc.isbf = 0; loc.atol = 0.002f; return; }
    if (ph == NPHASE - 1) { const int row = h1 % ML, col = h2 % D; const _Float16* hp = H16 + (size_t)row * D; double ss = 0; for (int k = 0; k < D; ++k) ss += dh16(hp + k) * dh16(hp + k);
        expv = dh16(hp + col) / sqrt(ss / D + 1e-6) * in[I_FINN][col]; loc.p = a.out + (size_t)row * D + col; loc.isbf = 0; loc.atol = 0.002f; return; }
    if (ph == 1 || ph == 10) {
        const int l = (ph == 1) ? 0 : 1, s = h2 % 3, b = h3 % 17; const int N = (s == 1) ? PINP : 2 * DFF; const int n = hsh(h3 + 5u) % N;
        const bf16_t* Wt = (const bf16_t*)(ws + WS_W + (s == 0 ? WL_W13A : s == 1 ? WL_WIN : WL_W13B)) + (size_t)n * D;
        double acc = 0; for (int k = 0; k < D; ++k) acc += (double)MOD[((size_t)l * 17 + b) * NMOD + 3 * s * D + k] * dbf(Wt[k]);
        expv = acc; loc.p = (const float*)(ws + WS_CB) + (size_t)l * CB_LAYER + (s == 0 ? CB_S0 : s == 1 ? CB_S1 : CB_S2) + (size_t)b * N + n; loc.isbf = 0; loc.atol = 0.002f; return; }
    const int l = (ph < 10) ? 0 : 1; int st = (ph < 10) ? ph - 2 : ph - 11; if (st >= 3) st += 1; if (st >= 6) st += 1;
    const bool last = (l == DEPTH - 1);
    const float* modl = MOD + (size_t)l * 17 * NMOD;
    const int Mlate = last ? ML : MT;
    const bf16_t* AO = (const bf16_t*)(ws + WS_AO);
    auto pickrow = [&](int M) -> int { const int q = s & 7; if (q == 0) return 0; if (q == 1) return M - 1; if (q == 2 && M > ML) return ML + (int)(h1 % MC); return (int)(h1 % (unsigned)M); };
    if (st == 0 || st == 8 || st == 2) {
        const int M = (st == 8) ? Mlate : MT; const int row = pickrow(M); const int b = row < ML ? row >> 11 : 16;
        const _Float16* hp = H16 + (size_t)row * D; const float* gain = in[st == 0 ? I_F1N : st == 2 ? I_MIXN : I_F2N] + l * D; const int si = st == 0 ? 0 : st == 2 ? 3 : 6;
        double ss = 0; for (int q = 0; q < D; ++q) ss += dh16(hp + q) * dh16(hp + q);
        const double rinv = 1.0 / sqrt(ss / D + 1e-6);
        if (st == 2) {
            const float* w = in[I_WIN] + (size_t)l * D * PIN;
            auto dotc = [&](int c) -> double { double x = 0; for (int k = 0; k < D; ++k) { const double xn = dh16(hp + k) * rinv * gain[k] * (1.0 + modl[(size_t)b * NMOD + (si + 1) * D + k]) + modl[(size_t)b * NMOD + si * D + k]; x += xn * w[(size_t)k * PIN + c]; } return x; };
            if ((s & 15) == 5) {
                const int pn = h2 & 3; double ss2 = 0; for (int c = 0; c < 256; ++c) { const double v = dotc(pn * 256 + c); ss2 += v * v; }
                expv = ss2; loc.p = (const float*)(ws + WS_RINV) + (size_t)row * 4 + pn; loc.isbf = 0; loc.atol = 0.5f; return; }
            const int c = h2 % PIN;
            if (c >= 1024 && c < 1088) { const int j = c - 1024, axis = j >> 5, half = (j >> 4) & 1, f = j & 15; const double xa = dotc(1024 + axis * 32 + f), xb = dotc(1024 + axis * 32 + 16 + f); double v;
                if (row < ML) { const int t = row & (SEQ - 1); const double pos = axis ? (t & 63) : (t >> 6); const double ang = pos * (double)powf(10000.f, -(float)f / 16.f); v = half ? xa * sin(ang) + xb * cos(ang) : xa * cos(ang) - xb * sin(ang); }
                else v = half ? xb : xa;
                expv = v; loc.p = (const bf16_t*)(BIG + BG_KR) + (size_t)row * 64 + axis * 32 + 8 * (f >> 2) + 4 * half + (f & 3); return; }
            expv = dotc(c);
            if (c < 1024) loc.p = (const bf16_t*)(BIG + BG_CQKV) + (size_t)row * 1024 + c;
            else { const int cc = c - 1088; loc.p = (const bf16_t*)(BIG + BG_NQKV) + (size_t)(cc >> 10) * MT * 1024 + (size_t)row * 1024 + (cc & 1023); }
            return; }
        const int j = h2 % DFF; const float* w1 = in[st == 0 ? I_F1W1 : I_F2W1] + (size_t)l * D * DFF; const float* w3 = in[st == 0 ? I_F1W3 : I_F2W3] + (size_t)l * D * DFF;
        double x = 0, y = 0;
        for (int k = 0; k < D; ++k) { const double xn = dh16(hp + k) * rinv * gain[k] * (1.0 + modl[(size_t)b * NMOD + (si + 1) * D + k]) + modl[(size_t)b * NMOD + si * D + k]; x += xn * w1[(size_t)k * DFF + j]; y += xn * w3[(size_t)k * DFF + j]; }
        expv = dsilu(x) * y; loc.p = (const bf16_t*)(BIG + BG_G) + (size_t)row * DFF + j; return; }
    if (st == 1 || st == 9) {
        const int M = (st == 9) ? Mlate : MT; const int row = pickrow(M), col = h2 % D; const int b = row < ML ? row >> 11 : 16; const float* w2 = in[st == 1 ? I_F1W2 : I_F2W2] + (size_t)l * DFF * D;
        const bf16_t* G = (const bf16_t*)(BIG + BG_G) + (size_t)row * DFF; double x = 0; for (int k = 0; k < DFF; ++k) x += dbf(G[k]) * w2[(size_t)k * D + col];
        expv = dh16(H16 + (size_t)row * D + col) + 0.5 * modl[(size_t)b * NMOD + (st == 1 ? 2 : 8) * D + col] * x;
        loc.p = H16 + (size_t)row * D + col; loc.isbf = 2; loc.atol = 0.004f; return; }
    if (st == 4) {
        const int row = pickrow(MT), idx = h2 % UPW; const bf16_t* cq = (const bf16_t*)(BIG + BG_CQKV) + (size_t)row * 1024; const float* sq4 = (const float*)(ws + WS_RINV) + (size_t)row * 4;
        const double rq_ = 1.0 / sqrt(((double)sq4[0] + sq4[1]) / 512 + 1e-6), rkv_ = 1.0 / sqrt(((double)sq4[2] + sq4[3]) / 512 + 1e-6);
        if (idx >= QW) { const int c = idx - QW; const float* w = in[I_WUKV] + (size_t)l * 512 * KVW; const float* gn = in[I_KVAN] + l * 512; double x = 0; for (int k = 0; k < 512; ++k) x += dbf(cq[512 + k]) * gn[k] * w[(size_t)k * KVW + c];
            expv = x * rkv_; loc.p = (const bf16_t*)(BIG + BG_KV) + (size_t)row * KVW + c; return; }
        const int h = idx / 192, d = idx % 192; const float* w = in[I_WUQ] + (size_t)l * 512 * QW; const float* gn = in[I_QAN] + l * 512;
        auto qv = [&](int dd) -> double { double x = 0; for (int k = 0; k < 512; ++k) x += dbf(cq[k]) * gn[k] * w[(size_t)k * QW + h * 192 + dd]; return x * rq_; };
        if (d < 128) { expv = qv(d); loc.p = (const bf16_t*)(BIG + BG_Q) + (size_t)row * QW + h * 192 + d; return; }
        const int j = d - 128, axis = j >> 5, half = (j >> 4) & 1, f = j & 15; const double xa = qv(128 + axis * 32 + f), xb = qv(128 + axis * 32 + 16 + f); double v;
        if (row < ML) { const int t = row & (SEQ - 1); const double pos = axis ? (t & 63) : (t >> 6); const double ang = pos * (double)powf(10000.f, -(float)f / 16.f); v = half ? xa * sin(ang) + xb * cos(ang) : xa * cos(ang) - xb * sin(ang); }
        else v = half ? xb : xa;
        expv = v; loc.p = (const bf16_t*)(BIG + BG_Q) + (size_t)row * QW + h * 192 + 128 + axis * 32 + 8 * (f >> 2) + 4 * half + (f & 3); return; }
    if (st == 7) {
        const int row = pickrow(Mlate), col = h2 % D; const int b = row < ML ? row >> 11 : 16; const float* w = in[I_WOUT] + (size_t)l * D * D; const bf16_t* ao = AO + (size_t)row * D;
        double sa = 0, sb = 0; for (int k = 0; k < 1024; ++k) { const double va = dbf(ao[k]), vb = dbf(ao[1024 + k]); sa += va * va; sb += vb * vb; }
        const double ra = 1.0 / sqrt(sa / 1024 + 1e-6), rb = 1.0 / sqrt(sb / 1024 + 1e-6); double x = 0;
        for (int k = 0; k < D; ++k) x += dbf(ao[k]) * (k < 1024 ? ra : rb) * in[I_OUTN][l * D + k] * w[(size_t)k * D + col];
        expv = dh16(H16 + (size_t)row * D + col) + (double)modl[(size_t)b * NMOD + 5 * D + col] * x; loc.p = H16 + (size_t)row * D + col; loc.isbf = 2; loc.atol = 0.004f; return; }
    (void)XN;
}
__global__ void dbg_attn(Args a, int ph, int mode) {
    __shared__ float sc[2560]; __shared__ float red[2];
    const int l = (ph < 10) ? 0 : 1; const bool last = (l == DEPTH - 1);
    const unsigned char* BIG = a.ws + WS_BIG; const bf16_t* XN = (const bf16_t*)(a.ws + WS_AO);
    unsigned* dw = (unsigned*)(a.ws + WS_CTL) + CW_DBG + ph * 4; float* EXPB = (float*)(a.ws + WS_DBG);
    const int s = blockIdx.x, d = threadIdx.x;
    const unsigned h1 = hsh(s * 2654435761u + 12345u), h2 = hsh(h1 + 99u);
    const bool wantctx = (!last) && ((s & 7) == 3);
    const int row = wantctx ? ML + (int)(h1 % MC) : ((s & 7) == 0 ? (int)((h1 % NBATCH) * SEQ) : (s & 7) == 1 ? (int)((h1 % NBATCH) * SEQ + SEQ - 1) : (int)(h1 % ML));
    const int grpB = (h2 >> 3) & 1, h = h2 & 7;
    const int b = row < ML ? row >> 11 : (row - ML) >> 8;
    const bf16_t* AOp = XN + (size_t)row * D + (grpB ? 1024 : 0) + h * 128 + d;
    if (mode == 1) { const float ev = EXPB[s * 128 + d]; const float av = __builtin_bit_cast(float, ((unsigned)*AOp) << 16); const float ratio = fabsf(av - ev) / (0.02f * fabsf(ev) + 0.003f);
        if (!(ratio <= 1.0f)) atomicAdd(dw, 1u); atomicMax(dw + 1, __float_as_uint(ratio == ratio ? ratio : 1e30f)); return; }
    const int nlat = row < ML ? (grpB ? 512 : 2048) : 0; const int nk = nlat + 256;
    const int t = row & (SEQ - 1), gr = t >> 6, qc = t & 63, rs = min(max(gr - 4, 0), 24), cs0 = min(max(qc - 8, 0), 48);
    const bf16_t* Q = (const bf16_t*)(BIG + BG_Q); const bf16_t* KV = (const bf16_t*)(BIG + BG_KV); const bf16_t* KR = (const bf16_t*)(BIG + BG_KR);
    const bf16_t* NQ = (const bf16_t*)(BIG + BG_NQKV); const bf16_t* NK = NQ + (size_t)MT * 1024; const bf16_t* NV = NK + (size_t)MT * 1024;
    for (int k = d; k < nk; k += 128) {
        int krow; bool valid = true; double bias = 0;
        if (k < nlat) { if (grpB) { const int kr = rs + (k >> 6), kc = k & 63; krow = b * SEQ + kr * 64 + kc; valid = (kc >= cs0) && (kc < cs0 + 16); if (valid) bias = a.in[I_RPB][((size_t)(l * 8 + h) * 15 + (kr - gr + 7)) * 31 + (kc - qc + 15)]; } else krow = b * SEQ + k; }
        else krow = ML + b * CTXL + (k - nlat);
        double x = 0;
        if (!grpB) { for (int q = 0; q < 128; ++q) x += dbf(Q[(size_t)row * QW + h * 192 + q]) * dbf(KV[(size_t)krow * KVW + h * 256 + q]); for (int q = 0; q < 64; ++q) x += dbf(Q[(size_t)row * QW + h * 192 + 128 + q]) * dbf(KR[(size_t)krow * 64 + q]); x *= (double)MLA_SCALE; }
        else { for (int q = 0; q < 128; ++q) x += dbf(NQ[(size_t)row * 1024 + h * 128 + q]) * dbf(NK[(size_t)krow * 1024 + h * 128 + q]); x = x * (double)NA_SCALE + bias; }
        sc[k] = valid ? (float)x : -1e30f;
    }
    __syncthreads();
    float mx = -1e30f; for (int k = 0; k < nk; ++k) mx = fmaxf(mx, sc[k]);
    double den = 0, acc = 0;
    for (int k = 0; k < nk; ++k) { const double p = exp((double)sc[k] - (double)mx); if (sc[k] < -1e29f) continue; den += p;
        int krow; if (k < nlat) krow = grpB ? b * SEQ + (rs + (k >> 6)) * 64 + (k & 63) : b * SEQ + k; else krow = ML + b * CTXL + (k - nlat);
        acc += p * (grpB ? dbf(NV[(size_t)krow * 1024 + h * 128 + d]) : dbf(KV[(size_t)krow * KVW + h * 256 + 128 + d])); }
    EXPB[s * 128 + d] = (float)(acc / den);
    (void)red;
}
__global__ void dbg_check(Args a, int ph, int mode) {
    const int s = blockIdx.x * blockDim.x + threadIdx.x;
    unsigned* dw = (unsigned*)(a.ws + WS_CTL) + CW_DBG + ph * 4; float* EXPB = (float*)(a.ws + WS_DBG);
    double ev; DbgLoc loc; dbg_sample(a, ph, s, ev, loc);
    if (!loc.p) return;
    if (mode == 0) { EXPB[s] = (float)ev; return; }
    const float e = EXPB[s]; const float av = loc.isbf == 1 ? __builtin_bit_cast(float, ((unsigned)*(const bf16_t*)loc.p) << 16) : loc.isbf == 2 ? (float)*(const _Float16*)loc.p : *(const float*)loc.p;
    const float ratio = fabsf(av - e) / (0.02f * fabsf(e) + loc.atol);
    if (!(ratio <= 1.0f)) atomicAdd(dw, 1u);
    atomicMax(dw + 1, __float_as_uint(ratio == ratio ? ratio : 1e30f));
}
__global__ void dbg_report(Args a) {
    const unsigned* dw = (const unsigned*)(a.ws + WS_CTL) + CW_DBG; int bad = -1; float ratio = 0;
    for (int p = 0; p < NPHASE; ++p) if (dw[p * 4] != 0u) { bad = p; ratio = __uint_as_float(dw[p * 4 + 1]); break; }
    if (bad < 0) return;
    float e = 10.f * log10f(fmaxf(ratio, 1e-3f)) + 10.f; e = fminf(fmaxf(rintf(e), 1.f), 99.f);
    const float v = 1e4f * sqrtf(e);
    for (size_t i = (size_t)blockIdx.x * blockDim.x + threadIdx.x; i < (size_t)ML * D; i += (size_t)gridDim.x * blockDim.x) a.out[i] = (i == 0) ? 1e6f * (float)(bad + 1) : v;
}
#endif

extern "C" void kernel_launch(void* const* d_in, const int* in_sizes, int n_in, void* d_out, int out_size, void* d_ws, size_t ws_size, hipStream_t stream) {
    static int grid = 0;
    if (grid == 0) {
        if (n_in != 24 || in_sizes[0] != ML * D || out_size != ML * D || ws_size < WS_END) { fprintf(stderr, "kernel_launch: built for 24 inputs, x/out of %d floats, >= %zu bytes of workspace; got n_in %d, in0 %d, out %d, ws %zu; nothing launched\n", ML * D, (size_t)WS_END, n_in, n_in > 0 ? in_sizes[0] : -1, out_size, ws_size); grid = -1; return; }
        int dev = 0, cus = 0, per_cu = 0;
        if (hipGetDevice(&dev) != hipSuccess || hipDeviceGetAttribute(&cus, hipDeviceAttributeMultiprocessorCount, dev) != hipSuccess) { fprintf(stderr, "kernel_launch: device query failed\n"); grid = -1; return; }
        if (hipFuncSetAttribute((const void*)mk_fwd, hipFuncAttributeMaxDynamicSharedMemorySize, LDS_BYTES) != hipSuccess) { fprintf(stderr, "kernel_launch: hipFuncSetAttribute failed\n"); grid = -1; return; }
        if (hipOccupancyMaxActiveBlocksPerMultiprocessor(&per_cu, (const void*)mk_fwd, 512, LDS_BYTES) != hipSuccess || per_cu < 1) fprintf(stderr, "kernel_launch: note: occupancy query reports %d workgroups per CU\n", per_cu);
        (void)hipGetLastError();
        grid = cus;
    }
    if (grid < 0) return;
    if (hipMemsetAsync((char*)d_ws + WS_CTL, 0, CTL_ZERO_BYTES, stream) != hipSuccess) { fprintf(stderr, "kernel_launch: memset failed\n"); return; }
    Args a{};
    for (int i = 0; i < 24; ++i) a.in[i] = (const float*)d_in[i];
    a.out = (float*)d_out; a.ws = (unsigned char*)d_ws;
#if MK_PER_PHASE || MK_DEBUG
    for (int ph = 0; ph < NPHASE; ++ph) {
#if MK_DEBUG
        const bool isattn = (ph == 6 || ph == 15);
        if (isattn) hipLaunchKernelGGL(dbg_attn, dim3(64), dim3(128), 0, stream, a, ph, 0); else hipLaunchKernelGGL(dbg_check, dim3(16), dim3(64), 0, stream, a, ph, 0);
#endif
        a.ph_lo = ph; a.ph_hi = ph + 1;
        hipLaunchKernelGGL(mk_fwd, dim3(grid), dim3(512), LDS_BYTES, stream, a);
#if MK_DEBUG
        if (isattn) hipLaunchKernelGGL(dbg_attn, dim3(64), dim3(128), 0, stream, a, ph, 1); else hipLaunchKernelGGL(dbg_check, dim3(16), dim3(64), 0, stream, a, ph, 1);
#endif
    }
#if MK_DEBUG
    hipLaunchKernelGGL(dbg_report, dim3(1024), dim3(256), 0, stream, a);
#endif
#else
    a.ph_lo = 0; a.ph_hi = NPHASE;
    hipLaunchKernelGGL(mk_fwd, dim3(grid), dim3(512), LDS_BYTES, stream, a);
#endif
    const hipError_t le = hipPeekAtLastError();
    if (le != hipSuccess) fprintf(stderr, "kernel_launch: launch failed: %s\n", hipGetErrorName(le));
}
```

```cpp
#include <hip/hip_runtime.h>
#include <cstdio>
#include <cstdint>

#ifndef MK_PER_PHASE
#define MK_PER_PHASE 0
#endif
#ifndef MK_DEBUG
#define MK_DEBUG 0
#endif

#define LAS __attribute__((address_space(3)))
#define GAS __attribute__((address_space(1)))
typedef unsigned short bf16_t;
typedef short bf16x8 __attribute__((ext_vector_type(8)));
typedef short s16x4 __attribute__((ext_vector_type(4)));
typedef float f32x2 __attribute__((ext_vector_type(2)));
typedef float f32x4 __attribute__((ext_vector_type(4)));
typedef float f32x16 __attribute__((ext_vector_type(16)));
typedef unsigned u32x2 __attribute__((ext_vector_type(2)));
typedef unsigned u32x4 __attribute__((ext_vector_type(4)));
typedef _Float16 f16x8 __attribute__((ext_vector_type(8)));

constexpr int D = 2048, NBATCH = 16, SEQ = 2048, CTXL = 256, DFF = 5632, DEPTH = 2;
constexpr int ML = NBATCH * SEQ, MC = NBATCH * CTXL, MT = ML + MC;
constexpr int NMOD = 9 * D;
constexpr int PIN = 4160, PINP = 4352;
constexpr int QW = 1536, KVW = 2048, UPW = QW + KVW;
constexpr float EPS = 1e-6f;
constexpr float MLA_SCALE = 0.07216878364870322f;
constexpr float NA_SCALE = 0.08838834764831845f;
constexpr int CV_I13 = (D / 64) * (2 * DFF / 32), CV_I2 = (DFF / 64) * (D / 32), CV_IIN = (D / 64) * (PINP / 32), CV_IUP = (512 / 64) * (UPW / 32), CV_IOUT = (D / 64) * (D / 32);
constexpr int CV_W13A = 0, CV_W2A = CV_I13, CV_W13B = CV_W2A + CV_I2, CV_W2B = CV_W13B + CV_I13, CV_WIN = CV_W2B + CV_I2, CV_WUP = CV_WIN + CV_IIN, CV_WOUT = CV_WUP + CV_IUP, CV_ALL = CV_WOUT + CV_IOUT;
constexpr int NPHASE = 20;

constexpr size_t MiB = 1u << 20;
constexpr size_t WS_CTL = 0, CTL_ZERO_BYTES = 1 * MiB;
constexpr size_t WS_MOD = 1 * MiB;
constexpr size_t WS_ROPE = 4 * MiB;
constexpr size_t WS_SMALL = WS_ROPE + 65536;
constexpr int SM_F1N = 0, SM_MIXN = 2 * D, SM_F2N = 4 * D, SM_OUTN = 6 * D, SM_FINN = 8 * D, SM_RPB = 9 * D, SM_TOTAL = 9 * D + 2 * 8 * 465;
constexpr size_t WS_RINV = 5 * MiB;
constexpr size_t WS_H16 = 6 * MiB;
constexpr size_t WS_W = 150 * MiB;
constexpr size_t WL_W13A = 0, WL_W2A = 44 * MiB, WL_W13B = 66 * MiB, WL_W2B = 110 * MiB, WL_WIN = 132 * MiB, WL_WUP = 149 * MiB, WL_WOUT = 153 * MiB, WL_SIZE = 161 * MiB;
constexpr size_t WS_XN = WS_W + WL_SIZE;
constexpr int XNP = D + 64;
constexpr size_t WS_BIG = WS_XN + 149 * MiB;
constexpr size_t BG_G = 0;
constexpr size_t BG_CQKV = 0, BG_NQKV = 72 * MiB, BG_KRF = 288 * MiB, BG_KR = 297 * MiB, BG_Q = 302 * MiB, BG_KV = 410 * MiB;
constexpr size_t WS_DBG = WS_BIG + 554 * MiB;
constexpr size_t WS_AO = WS_DBG + 1 * MiB;
constexpr size_t WS_SS = WS_AO + 144 * MiB;
constexpr size_t WS_CB = WS_SS + 2 * MiB;
constexpr int CB_S0 = 0, CB_S1 = 17 * 2 * DFF, CB_S2 = CB_S1 + 17 * PINP, CB_LAYER = CB_S2 + 17 * 2 * DFF;
constexpr size_t WS_END = WS_CB + 4 * MiB;
constexpr int CW_FIN = 135168;
constexpr int CW_SPK = 131072;
constexpr int CW_BAR = 4096;
constexpr int CW_DBG = 65536;

constexpr int RING_BYTES = 131072;
constexpr int SSL_OFF = RING_BYTES;
constexpr int LDSCTL_OFF = 143360, MISC_OFF = LDSCTL_OFF + 64;
constexpr int LDS_BYTES = 147456;

__device__ __forceinline__ unsigned cvt_pk_bf16(float lo, float hi) { unsigned r; asm volatile("v_cvt_pk_bf16_f32 %0, %1, %2" : "=v"(r) : "v"(lo), "v"(hi)); return r; }
__device__ __forceinline__ unsigned f2bf(float f) { unsigned u = __builtin_bit_cast(unsigned, f); return (u + 0x7fffu + ((u >> 16) & 1u)) >> 16; }
__device__ __forceinline__ float bf2f(unsigned b) { return __builtin_bit_cast(float, b << 16); }
typedef _Float16 f16x2 __attribute__((ext_vector_type(2)));
__device__ __forceinline__ unsigned cvt_pk_f16(float lo, float hi) { unsigned r; asm volatile("v_cvt_pk_f16_f32 %0, %1, %2" : "=v"(r) : "v"(lo), "v"(hi)); return r; }
typedef float f32x8 __attribute__((ext_vector_type(8)));
__device__ __forceinline__ void h8_to_f32(const u32x4 v, f32x4& lo, f32x4& hi) {
    const f32x8 f = __builtin_convertvector(__builtin_bit_cast(f16x8, v), f32x8);
    lo = (f32x4){f[0], f[1], f[2], f[3]}; hi = (f32x4){f[4], f[5], f[6], f[7]}; }
__device__ __forceinline__ int lane_now() { unsigned z = 0u; asm volatile("" : "+v"(z)); return (int)__builtin_amdgcn_mbcnt_hi(~0u, __builtin_amdgcn_mbcnt_lo(~0u, z)); }
__device__ __forceinline__ int opaque_tid(int wave) { return wave * 64 + lane_now(); }
__device__ __forceinline__ float shfl_xor_f(float v, int o, int lane) { return __builtin_bit_cast(float, __builtin_amdgcn_ds_bpermute((lane ^ o) << 2, __builtin_bit_cast(int, v))); }
__device__ __forceinline__ float wave_sum(float v, int lane) {
#pragma unroll
    for (int o = 1; o < 64; o <<= 1) v += shfl_xor_f(v, o, lane);
    return v;
}
__device__ __forceinline__ float silu_f(float x) { return x * __builtin_amdgcn_rcpf(1.0f + __builtin_amdgcn_exp2f(-1.4426950408889634f * x)); }
#define LDS_WAIT() asm volatile("s_waitcnt lgkmcnt(0)" ::: "memory")
#define VM_WAIT() asm volatile("s_waitcnt vmcnt(0)" ::: "memory")

#ifndef MK_SPK_SKEW
#define MK_SPK_SKEW 6
#endif
namespace pg8 {
constexpr int BM = 256, BK = 64, HALF = 128, HTB = HALF * BK * 2, STAGE_BYTES = 8 * HTB, NXCD = 8;
__host__ __device__ __forceinline__ int lds_byte(int r, int c) { const int st = (r >> 4) * 2 + (c >> 5), rr = r & 15, cc = c & 31, ob = rr * 64 + cc * 2; return st * 1024 + (ob ^ (((ob >> 9) & 1) << 5)); }
__host__ __device__ __forceinline__ void stage_rc(int b, int& R, int& C) { const int st = b / 1024, sb = b % 1024, swz = sb ^ (((sb >> 9) & 1) << 5); R = (st >> 1) * 16 + swz / 64; C = (st & 1) * 32 + (swz % 64) / 2; }
__host__ __device__ __forceinline__ int perm32(int rho) { const int n = rho >> 4, i = rho & 15; return 8 * (i >> 2) + 4 * n + (i & 3); }

struct Unit { int pm, pn, acol, tail; };
struct Gemm { const bf16_t* A; const bf16_t* Bt; int lda, ldb, K; };
struct Order {
    unsigned char* spk; int epoch;
    int nM, nN, nwg, G, c, split_pn, split_acol, WGM;
    __device__ void init(int nM_, int nN_, int G_, int c_, int wgm_, int split_pn_ = 1 << 30, int split_acol_ = 0) { nM = nM_; nN = nN_; nwg = nM * nN; G = G_; c = c_; WGM = wgm_; split_pn = split_pn_; split_acol = split_acol_; spk = nullptr; epoch = 0; }
    __device__ bool next(int i, Unit& u) const {
        long L = (long)i * G + c; u.tail = 0;
        if (epoch != 0 && i == nwg / G && (nwg % G) * 2 == G) {
            const int xcd = c % NXCD, off = c / NXCD, tl = (off >> 1) * NXCD + xcd;
            L = (long)i * G + tl; u.tail = (off & 1) ? -(tl + 1) : (tl + 1);
        } else if (L >= nwg) return false;
        int wgid = (int)L; { const int q = nwg / NXCD, r = nwg % NXCD, xcd = wgid % NXCD, off = wgid / NXCD; wgid = (xcd < r ? xcd * (q + 1) : r * (q + 1) + (xcd - r) * q) + off; }
        const int nig = WGM * nN, gid = wgid / nig, fm = gid * WGM, gsz = (nM - fm) < WGM ? (nM - fm) : WGM;
        u.pm = fm + ((wgid % nig) % gsz); u.pn = (wgid % nig) / gsz; u.acol = (u.pn >= split_pn) ? split_acol : 0; return true;
    }
};

template <class Epi, bool ALIGN_EPI, bool SP2, bool SPK = false>
__device__ __forceinline__ void gemm_phase(LAS unsigned char* lds, const int wave, const Gemm g, const Order& S, const Epi& E) {
    const int tid = opaque_tid(wave), wid = __builtin_amdgcn_readfirstlane(tid >> 6), lane = tid & 63, wr = wid >> 2, wc = wid & 3, fr = lane & 15, fq = lane >> 4;
    const int K = g.K, nt = K / BK;
    unsigned voffA[2], voffB[2];
#pragma unroll
    for (int i = 0; i < 2; ++i) { int R, C; stage_rc(tid * 16 + i * 8192, R, C); const int Rb = Epi::PERM ? ((R & ~31) + perm32(R & 31)) : R;
        voffA[i] = (unsigned)(R * g.lda + C) * 2u; voffB[i] = (unsigned)(Rb * g.ldb + C) * 2u; }
    const size_t kstep = (size_t)(BK * 2);
    const size_t hstepA = (size_t)HALF * g.lda * 2, hstepB = (size_t)HALF * g.ldb * 2;
    const size_t tstepA = 2 * hstepA, tstepB = 2 * hstepB;
    const unsigned ldsw = (unsigned)wid * 1024u;
    const int aoff = lds_byte(wr * 64 + fr, fq * 8), boff = lds_byte(wc * 32 + fr, fq * 8);
#define PG8_SA(b, h) (((b) * 2 + (h)) * HTB)
#define PG8_SB(b, h) ((4 + (b) * 2 + (h)) * HTB)
#define PG8_STAGE(bufoff, gbase, voff) do { _Pragma("unroll") for (int _i = 0; _i < 2; ++_i) \
        __builtin_amdgcn_global_load_lds((const unsigned*)((const char*)(gbase) + (voff)[_i]), (LAS unsigned*)(lds + (bufoff) + ldsw + _i * 8192), 16, 0, 0); } while (0)
#define PG8_LDA(dst, b, h) do { _Pragma("unroll") for (int m = 0; m < 4; ++m) _Pragma("unroll") for (int k = 0; k < 2; ++k) dst[m][k] = *(const LAS bf16x8*)(lds + PG8_SA(b, h) + aoff + m * 2048 + k * 1024); } while (0)
#define PG8_LDB(dst, b, h) do { _Pragma("unroll") for (int n = 0; n < 2; ++n) _Pragma("unroll") for (int k = 0; k < 2; ++k) dst[n][k] = *(const LAS bf16x8*)(lds + PG8_SB(b, h) + boff + n * 2048 + k * 1024); } while (0)
#define PG8_MMA(ai, bj, At, Bt) do { __builtin_amdgcn_s_setprio(1); _Pragma("unroll") for (int m = 0; m < 4; ++m) _Pragma("unroll") for (int n = 0; n < 2; ++n) _Pragma("unroll") for (int k = 0; k < 2; ++k) \
        acc[ai][bj][m][n] = __builtin_amdgcn_mfma_f32_16x16x32_bf16(Bt[n][k], At[m][k], acc[ai][bj][m][n], 0, 0, 0); __builtin_amdgcn_s_setprio(0); } while (0)
#define PG8_WAIT_V(n) asm volatile("s_waitcnt vmcnt(" #n ")" ::: "memory")
#define PG8_WAIT_L(n) asm volatile("s_waitcnt lgkmcnt(" #n ")" ::: "memory")
#define PG8_BAR __builtin_amdgcn_s_barrier()
#define PG8_SCHED __builtin_amdgcn_sched_barrier(0)
    Unit cur, nxt; int ui = 0;
    if (!S.next(0, cur)) return;
    f32x4 acc[2][2][4][2];
#pragma unroll
    for (int a = 0; a < 2; ++a)
#pragma unroll
        for (int b = 0; b < 2; ++b)
#pragma unroll
            for (int m = 0; m < 4; ++m)
#pragma unroll
                for (int n = 0; n < 2; ++n) acc[a][b][m][n] = (f32x4){0.f, 0.f, 0.f, 0.f};
    bf16x8 At[4][2], B0[2][2], B1[2][2];
    const int ntb = ((nt >> 1) - (SPK ? MK_SPK_SKEW : 0)) & ~1;
#define PG8_KOFS(u) ((SPK && (u).tail > 0) ? (size_t)ntb * kstep : (size_t)0)
    const char* cA = (const char*)g.A + (size_t)cur.pm * tstepA + (size_t)cur.acol * 2 + PG8_KOFS(cur); const char* cB = (const char*)g.Bt + (size_t)cur.pn * tstepB + PG8_KOFS(cur);
    E.panel_setup(cur, -1, tid);
    typename Epi::Pre pre = E.pre_load(cur, tid);
    int prev_pm = -1;
    if constexpr (SP2) {
        PG8_STAGE(PG8_SB(0, 0), cB, voffB); PG8_STAGE(PG8_SB(0, 1), cB + hstepB, voffB); PG8_STAGE(PG8_SA(0, 0), cA, voffA); PG8_STAGE(PG8_SA(0, 1), cA + hstepA, voffA);
        if (wr == 1) PG8_BAR;
        PG8_WAIT_V(2); PG8_BAR;
        PG8_STAGE(PG8_SB(1, 0), cB + kstep, voffB); PG8_STAGE(PG8_SA(1, 0), cA + kstep, voffA); PG8_STAGE(PG8_SB(1, 1), cB + hstepB + kstep, voffB);
        PG8_WAIT_V(6); PG8_BAR;
    } else {
        PG8_STAGE(PG8_SB(0, 0), cB, voffB); PG8_STAGE(PG8_SA(0, 0), cA, voffA); PG8_STAGE(PG8_SB(0, 1), cB + hstepB, voffB); PG8_STAGE(PG8_SA(0, 1), cA + hstepA, voffA);
        if (wr == 1) PG8_BAR;
        PG8_WAIT_V(4); PG8_BAR;
        PG8_STAGE(PG8_SB(1, 0), cB + kstep, voffB); PG8_STAGE(PG8_SA(1, 0), cA + kstep, voffA); PG8_STAGE(PG8_SB(1, 1), cB + hstepB + kstep, voffB);
        PG8_WAIT_V(6); PG8_BAR;
    }
    for (;;) {
        const bool has_next = S.next(ui + 1, nxt);
        const char* nA = has_next ? (const char*)g.A + (size_t)nxt.pm * tstepA + (size_t)nxt.acol * 2 + PG8_KOFS(nxt) : cA; const char* nB = has_next ? (const char*)g.Bt + (size_t)nxt.pn * tstepB + PG8_KOFS(nxt) : cB;
        const int ntu = (SPK && cur.tail != 0) ? (cur.tail > 0 ? nt - ntb : ntb) : nt;
        for (int t = 0; t < ntu; t += 2) {
            const bool last = (t == ntu - 2);
            const char* a1 = cA + (size_t)(t + 1) * kstep;
            const char* a2 = last ? nA : cA + (size_t)(t + 2) * kstep; const char* b2 = last ? nB : cB + (size_t)(t + 2) * kstep;
            const char* a3 = a2 + kstep; const char* b3 = b2 + kstep;
            if constexpr (Epi::MIDSCALE) { if (t == nt / 2) E.mid(acc, wr, fr); }
            if constexpr (SP2) {
            PG8_LDB(B0, 0, 0); PG8_LDB(B1, 0, 1); PG8_SCHED; PG8_LDA(At, 0, 0); PG8_STAGE(PG8_SA(1, 1), a1 + hstepA, voffA);
            PG8_WAIT_V(8); PG8_WAIT_L(0); PG8_BAR; PG8_MMA(0, 0, At, B0); PG8_MMA(0, 1, At, B1); PG8_BAR; PG8_SCHED;
            PG8_LDA(At, 0, 1); PG8_STAGE(PG8_SB(0, 0), b2, voffB); PG8_STAGE(PG8_SB(0, 1), b2 + hstepB, voffB); PG8_STAGE(PG8_SA(0, 0), a2, voffA);
            PG8_WAIT_V(8); PG8_WAIT_L(0); PG8_BAR; PG8_MMA(1, 0, At, B0); PG8_MMA(1, 1, At, B1); PG8_BAR; PG8_SCHED;
            PG8_LDB(B0, 1, 0); PG8_LDB(B1, 1, 1); PG8_SCHED; PG8_LDA(At, 1, 0); PG8_STAGE(PG8_SA(0, 1), a2 + hstepA, voffA);
            PG8_WAIT_V(8); PG8_WAIT_L(0); PG8_BAR; PG8_MMA(0, 0, At, B0); PG8_MMA(0, 1, At, B1); PG8_BAR; PG8_SCHED;
            PG8_LDA(At, 1, 1); PG8_STAGE(PG8_SB(1, 0), b3, voffB); PG8_STAGE(PG8_SB(1, 1), b3 + hstepB, voffB); PG8_STAGE(PG8_SA(1, 0), a3, voffA);
            PG8_WAIT_V(8); PG8_WAIT_L(0); PG8_BAR; PG8_MMA(1, 0, At, B0); PG8_MMA(1, 1, At, B1); PG8_BAR; PG8_SCHED;
            } else {
            PG8_LDB(B0, 0, 0); PG8_SCHED; PG8_LDA(At, 0, 0); PG8_STAGE(PG8_SA(1, 1), a1 + hstepA, voffA);
            PG8_WAIT_L(8); PG8_BAR; PG8_WAIT_L(0); PG8_MMA(0, 0, At, B0); PG8_BAR; PG8_SCHED;
            PG8_LDB(B1, 0, 1); PG8_STAGE(PG8_SB(0, 0), b2, voffB);
            PG8_BAR; PG8_WAIT_L(0); PG8_MMA(0, 1, At, B1); PG8_BAR;
            PG8_LDA(At, 0, 1); PG8_STAGE(PG8_SA(0, 0), a2, voffA);
            PG8_BAR; PG8_WAIT_L(0); PG8_MMA(1, 0, At, B0); PG8_BAR; PG8_SCHED;
            PG8_STAGE(PG8_SB(0, 1), b2 + hstepB, voffB);
            PG8_WAIT_V(6); PG8_BAR; PG8_MMA(1, 1, At, B1); PG8_BAR;
            PG8_LDB(B0, 1, 0); PG8_SCHED; PG8_LDA(At, 1, 0); PG8_STAGE(PG8_SA(0, 1), a2 + hstepA, voffA);
            PG8_WAIT_L(8); PG8_BAR; PG8_WAIT_L(0); PG8_MMA(0, 0, At, B0); PG8_BAR; PG8_SCHED;
            PG8_LDB(B1, 1, 1); PG8_STAGE(PG8_SB(1, 0), b3, voffB);
            PG8_BAR; PG8_WAIT_L(0); PG8_MMA(0, 1, At, B1); PG8_BAR;
            PG8_LDA(At, 1, 1); PG8_STAGE(PG8_SA(1, 0), a3, voffA);
            PG8_BAR; PG8_WAIT_L(0); PG8_MMA(1, 0, At, B0); PG8_BAR; PG8_SCHED;
            PG8_STAGE(PG8_SB(1, 1), b3 + hstepB, voffB);
            PG8_WAIT_V(6); PG8_BAR; PG8_MMA(1, 1, At, B1); PG8_BAR;
            }
        }
        if constexpr (ALIGN_EPI) { if (wr == 0) PG8_BAR; }
        if constexpr (SPK) {
            if (cur.tail > 0) {
                unsigned* flag = (unsigned*)(S.spk + WS_CTL) + CW_SPK + (cur.tail - 1) * 16;
                if (wave == 0 && lane_now() == 0) { for (unsigned spins = 0; spins < (1u << 22) && __hip_atomic_load(flag, __ATOMIC_RELAXED, __HIP_MEMORY_SCOPE_AGENT) != (unsigned)S.epoch; ++spins) __builtin_amdgcn_s_sleep(2);
                    __builtin_amdgcn_fence(__ATOMIC_ACQUIRE, "agent"); asm volatile("s_waitcnt vmcnt(0)" ::: "memory"); }
                __syncthreads();
            }
        }
        E(acc, cur, pre, prev_pm, wr, wc, fr, fq);
        if constexpr (SPK) {
            if (cur.tail < 0) {
                unsigned* flag = (unsigned*)(S.spk + WS_CTL) + CW_SPK + (-cur.tail - 1) * 16;
                asm volatile("s_waitcnt vmcnt(0)" ::: "memory");
                __syncthreads();
                if (wave == 0 && lane_now() == 0) { __builtin_amdgcn_fence(__ATOMIC_RELEASE, "agent"); asm volatile("s_waitcnt vmcnt(0)" ::: "memory"); __hip_atomic_store(flag, (unsigned)S.epoch, __ATOMIC_RELAXED, __HIP_MEMORY_SCOPE_AGENT); }
            }
        }
        prev_pm = cur.pm;
        if (!has_next) break;
        E.panel_setup(nxt, prev_pm, tid);
        pre = E.pre_load(nxt, tid);
#pragma unroll
        for (int a = 0; a < 2; ++a)
#pragma unroll
            for (int b = 0; b < 2; ++b)
#pragma unroll
                for (int m = 0; m < 4; ++m)
#pragma unroll
                    for (int n = 0; n < 2; ++n) acc[a][b][m][n] = (f32x4){0.f, 0.f, 0.f, 0.f};
        cur = nxt; cA = nA; cB = nB; ++ui;
        if constexpr (ALIGN_EPI) { if (wr == 1) PG8_BAR; }
    }
    PG8_WAIT_V(0);
    if constexpr (!ALIGN_EPI) { if (wr == 0) PG8_BAR; }
    PG8_BAR;
#undef PG8_KOFS
#undef PG8_SA
#undef PG8_SB
#undef PG8_STAGE
#undef PG8_LDA
#undef PG8_LDB
#undef PG8_MMA
#undef PG8_WAIT_V
#undef PG8_WAIT_L
#undef PG8_BAR
#undef PG8_SCHED
}

struct PreNone { };
struct PreSS { f32x4 v; };
__device__ __forceinline__ PreSS ss_pre_load(const float* SS, const Unit& u, int tid) { PreSS p; p.v = *(const f32x4*)(SS + ((size_t)u.pm * BM + (tid >> 1)) * 8 + (tid & 1) * 4); return p; }
__device__ __forceinline__ void rinv_from_pre(const PreSS& p, bool rebuild, int wr, int wc, int fr, int fq, float (&ri)[8]) {
    LAS float* sl = (LAS float*)(uintptr_t)SSL_OFF;
    if (rebuild) {
        const int t = (wr * 4 + wc) * 64 + fq * 16 + fr;
        asm volatile("s_waitcnt lgkmcnt(0)" ::: "memory"); __builtin_amdgcn_s_barrier(); asm volatile("" ::: "memory");
        sl[t] = (p.v[0] + p.v[1]) + (p.v[2] + p.v[3]);
        asm volatile("s_waitcnt lgkmcnt(0)" ::: "memory"); __builtin_amdgcn_s_barrier(); asm volatile("" ::: "memory");
    }
#pragma unroll
    for (int q = 0; q < 8; ++q) { const f32x2 s = *(const LAS f32x2*)(sl + (wr * 64 + fr + (q >> 2) * HALF + (q & 3) * 16) * 2); ri[q] = __builtin_amdgcn_rsqf((s[0] + s[1]) * (1.0f / D) + EPS); }
}
struct EpiSwiGLU {
    static constexpr bool PERM = true, MIDSCALE = false; typedef PreSS Pre;
    __device__ __forceinline__ void panel_setup(const Unit&, int, int) const {}
    bf16_t* G; int ldg; const float* SS; const float* cb;
    __device__ __forceinline__ Pre pre_load(const Unit& u, int tid) const { return ss_pre_load(SS, u, tid); }
    __device__ __forceinline__ void operator()(f32x4 (&acc)[2][2][4][2], const Unit& u, const Pre& pre, int prev_pm, int wr, int wc, int fr, int fq) const {
        const int row0 = u.pm * BM + wr * 64 + fr, col0 = u.pn * HALF + wc * 32 + 8 * fq;
        const int b = (u.pm < ML / BM) ? (u.pm >> 3) : 16;
        const float* cp = cb + (size_t)b * (2 * DFF) + u.pn * BM + wc * 32 + 8 * fq;
        const f32x4 ca0 = *(const f32x4*)cp, ca1 = *(const f32x4*)(cp + 4), cb0 = *(const f32x4*)(cp + HALF), cb1 = *(const f32x4*)(cp + HALF + 4);
        float rinv[8]; rinv_from_pre(pre, u.pm != prev_pm, wr, wc, fr, fq, rinv);
#pragma unroll
        for (int ai = 0; ai < 2; ++ai)
#pragma unroll
            for (int m = 0; m < 4; ++m) {
                const int row = row0 + ai * HALF + m * 16;
                const float ri = rinv[ai * 4 + m];
                bf16_t* rowp = G + (size_t)row * ldg + col0;
                const f32x4 a0 = acc[ai][0][m][0] * ri + ca0, a1 = acc[ai][0][m][1] * ri + ca1, b0 = acc[ai][1][m][0] * ri + cb0, b1 = acc[ai][1][m][1] * ri + cb1;
                float g[8];
#pragma unroll
                for (int i = 0; i < 4; ++i) { g[i] = silu_f(a0[i]) * b0[i]; g[4 + i] = silu_f(a1[i]) * b1[i]; }
                u32x4 w; w.x = cvt_pk_bf16(g[0], g[1]); w.y = cvt_pk_bf16(g[2], g[3]); w.z = cvt_pk_bf16(g[4], g[5]); w.w = cvt_pk_bf16(g[6], g[7]);
                *(u32x4*)rowp = w;
            }
    }
};
template <bool MS> struct EpiResid {
    static constexpr bool PERM = true, MIDSCALE = MS; typedef PreNone Pre;
    __device__ __forceinline__ Pre pre_load(const Unit&, int) const { return Pre{}; }
    __device__ __forceinline__ void panel_setup(const Unit& u, int prev_pm, int tid) const {
        if constexpr (MS) { if (u.pm != prev_pm || u.tail < 0) {
            LAS f32x2* tb = (LAS f32x2*)(uintptr_t)(SSL_OFF + 8192);
            asm volatile("s_waitcnt lgkmcnt(0)" ::: "memory"); __builtin_amdgcn_s_barrier(); asm volatile("" : "+v"(tid) :: "memory");
            if (tid < BM) { const float* sp = (const float*)(ws + WS_BIG + BG_KRF) + ((size_t)u.pm * BM + tid) * 16;
                const f32x4 a0 = *(const f32x4*)sp, a1 = *(const f32x4*)(sp + 4), b0 = *(const f32x4*)(sp + 8), b1 = *(const f32x4*)(sp + 12);
                const float ra = __builtin_amdgcn_rsqf((((a0[0] + a0[1]) + (a0[2] + a0[3])) + ((a1[0] + a1[1]) + (a1[2] + a1[3]))) * (1.0f / 1024.f) + EPS);
                const float rb = __builtin_amdgcn_rsqf((((b0[0] + b0[1]) + (b0[2] + b0[3])) + ((b1[0] + b1[1]) + (b1[2] + b1[3]))) * (1.0f / 1024.f) + EPS);
                tb[tid] = (f32x2){ra / rb, u.tail < 0 ? ra : rb}; }
            asm volatile("s_waitcnt lgkmcnt(0)" ::: "memory"); __builtin_amdgcn_s_barrier(); asm volatile("" ::: "memory");
        } }
    }
    __device__ __forceinline__ void mid(f32x4 (&acc)[2][2][4][2], int wr, int fr) const {
        const LAS f32x2* tb = (const LAS f32x2*)(uintptr_t)(SSL_OFF + 8192);
#pragma unroll
        for (int ai = 0; ai < 2; ++ai)
#pragma unroll
            for (int m = 0; m < 4; ++m) { const float r = tb[wr * 64 + fr + ai * HALF + m * 16][0];
#pragma unroll
                for (int bj = 0; bj < 2; ++bj) { acc[ai][bj][m][0] *= r; acc[ai][bj][m][1] *= r; } }
    }
    unsigned char* ws; float* out;
    int l, gidx; float scale; int emit, nvec, ln, sidxn, dst_out;
    __device__ __forceinline__ void operator()(f32x4 (&acc)[2][2][4][2], const Unit& u, const Pre&, int, int wr, int wc, int fr, int fq) const {
        const int emit_ = (u.tail < 0) ? 0 : emit;
        unsigned char* w_ = ws; float* o_ = out; asm volatile("" : "+s"(w_), "+s"(o_));
        { const int ln_ = lane_now(); fr = ln_ & 15; fq = ln_ >> 4; }
        const float* modl = (const float*)(w_ + WS_MOD) + (size_t)l * 17 * NMOD; const float* modn = (const float*)(w_ + WS_MOD) + (size_t)ln * 17 * NMOD;
        const float* gn = (const float*)(w_ + WS_SMALL) + nvec; float* SS = (float*)(w_ + WS_SS);
        LAS float* ssl = (LAS float*)(uintptr_t)SSL_OFF;
        const bool lat = u.pm < ML / BM;
        const int b = lat ? (u.pm >> 3) : 16;
        const float* gate = modl + (size_t)b * NMOD + gidx * D;
        const int col0 = u.pn * BM + wc * 32 + 8 * fq, r0 = wr * 64 + fr;
        const unsigned e0 = (unsigned)(r0 * D + col0);
        GAS char* hb = (GAS char*)(w_ + WS_H16) + (size_t)u.pm * BM * D * 2;
        GAS char* xnb = (GAS char*)(w_ + WS_XN) + (size_t)u.pm * BM * XNP * 2;
        const unsigned e0x = (unsigned)(r0 * XNP + col0);
        GAS float* ob = (GAS float*)o_ + (size_t)u.pm * BM * D;
        if constexpr (MS) { const LAS f32x2* tb = (const LAS f32x2*)(uintptr_t)(SSL_OFF + 8192);
#pragma unroll
            for (int ai = 0; ai < 2; ++ai)
#pragma unroll
                for (int m = 0; m < 4; ++m) { const float r = tb[r0 + ai * HALF + m * 16][1];
#pragma unroll
                    for (int bj = 0; bj < 2; ++bj) { acc[ai][bj][m][0] *= r; acc[ai][bj][m][1] *= r; } } }
#pragma unroll
        for (int bj = 0; bj < 2; ++bj) {
            const int c = col0 + bj * HALF;
            const f32x4 gv0 = *(const f32x4*)(gate + c) * scale, gv1 = *(const f32x4*)(gate + c + 4) * scale;
#pragma unroll
            for (int ai = 0; ai < 2; ++ai) {
                u32x4 s[4];
#pragma unroll
                for (int m = 0; m < 4; ++m) s[m] = *(const GAS u32x4*)((hb + (size_t)(((ai * HALF + m * 16) * D + bj * HALF) * 2)) + e0 * 2u);
#pragma unroll
                for (int m = 0; m < 4; ++m) { f32x4 s0, s1; h8_to_f32(s[m], s0, s1);
                    acc[ai][bj][m][0] = s0 + gv0 * acc[ai][bj][m][0]; acc[ai][bj][m][1] = s1 + gv1 * acc[ai][bj][m][1]; }
            }
            asm volatile("" ::: "memory");
        }
        if (dst_out) {
            float sq[8];
#pragma unroll
            for (int q = 0; q < 8; ++q) { sq[q] = 0.f;
#pragma unroll
                for (int bj = 0; bj < 2; ++bj) { const f32x4 h0 = acc[q >> 2][bj][q & 3][0], h1 = acc[q >> 2][bj][q & 3][1];
                    sq[q] += ((h0[0] * h0[0] + h0[1] * h0[1]) + (h0[2] * h0[2] + h0[3] * h0[3])) + ((h1[0] * h1[0] + h1[1] * h1[1]) + (h1[2] * h1[2] + h1[3] * h1[3])); } }
            { const int ln2 = lane_now(), r0b = wr * 64 + (ln2 & 15);
#pragma unroll
              for (int q = 0; q < 8; ++q) { float v = sq[q]; v += shfl_xor_f(v, 16, ln2); v += shfl_xor_f(v, 32, ln2); if (ln2 < 16) ssl[(r0b + (q >> 2) * HALF + (q & 3) * 16) * 4 + wc] = v; } }
            asm volatile("s_waitcnt lgkmcnt(0)" ::: "memory"); __builtin_amdgcn_s_barrier(); asm volatile("" ::: "memory");
            const int t = (wr * 4 + wc) * 64 + lane_now();
            if (t < BM) { const f32x4 p = *(const LAS f32x4*)(ssl + t * 4); SS[((size_t)u.pm * BM + t) * 8 + u.pn] = (p[0] + p[1]) + (p[2] + p[3]); }
            asm volatile("s_waitcnt vmcnt(0)" ::: "memory");
            __syncthreads();
            if (t == 0) { unsigned* cnt = (unsigned*)(w_ + WS_CTL) + CW_FIN + u.pm * 16;
                __builtin_amdgcn_fence(__ATOMIC_RELEASE, "agent"); asm volatile("s_waitcnt vmcnt(0)" ::: "memory");
                __hip_atomic_fetch_add(cnt, 1u, __ATOMIC_RELAXED, __HIP_MEMORY_SCOPE_AGENT);
                for (unsigned spins = 0; spins < (1u << 22) && __hip_atomic_load(cnt, __ATOMIC_RELAXED, __HIP_MEMORY_SCOPE_AGENT) < 8u; ++spins) __builtin_amdgcn_s_sleep(2);
                __builtin_amdgcn_fence(__ATOMIC_ACQUIRE, "agent"); asm volatile("s_waitcnt vmcnt(0)" ::: "memory"); }
            __syncthreads();
            if (t < BM) { const float* sp = SS + ((size_t)u.pm * BM + t) * 8; const f32x4 a = *(const f32x4*)sp, b2 = *(const f32x4*)(sp + 4);
                ssl[t] = 1.0f / sqrtf((((a[0] + a[1]) + (a[2] + a[3])) + ((b2[0] + b2[1]) + (b2[2] + b2[3]))) * (1.0f / D) + EPS); }
            asm volatile("s_waitcnt lgkmcnt(0)" ::: "memory"); __builtin_amdgcn_s_barrier(); asm volatile("" ::: "memory");
            const float* gf = (const float*)(w_ + WS_SMALL) + SM_FINN;
            float ri[8];
            { const int r0c = wr * 64 + (lane_now() & 15);
#pragma unroll
              for (int q = 0; q < 8; ++q) ri[q] = ssl[r0c + (q >> 2) * HALF + (q & 3) * 16]; }
#pragma unroll
            for (int bj = 0; bj < 2; ++bj) { const int c = col0 + bj * HALF; const f32x4 g0 = *(const f32x4*)(gf + c), g1 = *(const f32x4*)(gf + c + 4);
#pragma unroll
                for (int q = 0; q < 8; ++q) { const size_t co = (size_t)(((q >> 2) * HALF + (q & 3) * 16) * D + bj * HALF);
                    const f32x4 h0 = acc[q >> 2][bj][q & 3][0] * ri[q] * g0, h1 = acc[q >> 2][bj][q & 3][1] * ri[q] * g1;
                    *(GAS f32x4*)((GAS char*)(ob + co) + e0 * 4u) = h0; *(GAS f32x4*)((GAS char*)(ob + co + 4) + e0 * 4u) = h1; } }
            return;
        }
        float ssq[8];
#pragma unroll
        for (int q = 0; q < 8; ++q) ssq[q] = 0.f;
#pragma unroll
        for (int bj = 0; bj < 2; ++bj) {
            f32x4 gs0 = (f32x4){0.f, 0.f, 0.f, 0.f}, gs1 = gs0;
            if (emit_) { const int c = col0 + bj * HALF; const float* mp = modn + (size_t)b * NMOD + sidxn * D + c; gs0 = *(const f32x4*)(gn + c) * (*(const f32x4*)mp + 1.0f); gs1 = *(const f32x4*)(gn + c + 4) * (*(const f32x4*)(mp + 4) + 1.0f); }
#pragma unroll
            for (int q = 0; q < 8; ++q) { const size_t co = (size_t)(((q >> 2) * HALF + (q & 3) * 16) * D + bj * HALF);
                const f32x4 h0 = acc[q >> 2][bj][q & 3][0], h1 = acc[q >> 2][bj][q & 3][1];
                { u32x4 hv; hv.x = cvt_pk_f16(h0[0], h0[1]); hv.y = cvt_pk_f16(h0[2], h0[3]); hv.z = cvt_pk_f16(h1[0], h1[1]); hv.w = cvt_pk_f16(h1[2], h1[3]); *(GAS u32x4*)((hb + co * 2) + e0 * 2u) = hv; }
                if (emit_) { ssq[q] += ((h0[0] * h0[0] + h0[1] * h0[1]) + (h0[2] * h0[2] + h0[3] * h0[3])) + ((h1[0] * h1[0] + h1[1] * h1[1]) + (h1[2] * h1[2] + h1[3] * h1[3]));
                    const f32x4 a0 = h0 * gs0, a1 = h1 * gs1;
                    u32x4 w; w.x = cvt_pk_bf16(a0[0], a0[1]); w.y = cvt_pk_bf16(a0[2], a0[3]); w.z = cvt_pk_bf16(a1[0], a1[1]); w.w = cvt_pk_bf16(a1[2], a1[3]); *(GAS u32x4*)((xnb + (size_t)(((q >> 2) * HALF + (q & 3) * 16) * XNP + bj * HALF) * 2) + e0x * 2u) = w; } }
        }
        if (emit_) {
#pragma unroll
            for (int q = 0; q < 8; ++q) { float v = ssq[q]; v += shfl_xor_f(v, 16, fq * 16 + fr); v += shfl_xor_f(v, 32, fq * 16 + fr); if (fq == 0) ssl[(r0 + (q >> 2) * HALF + (q & 3) * 16) * 4 + wc] = v; }
        }
        if (emit_) {
            asm volatile("s_waitcnt lgkmcnt(0)" ::: "memory"); __builtin_amdgcn_s_barrier(); asm volatile("" ::: "memory");
            const int t = (wr * 4 + wc) * 64 + fq * 16 + fr;
            if (t < BM) { const f32x4 p = *(const LAS f32x4*)(ssl + t * 4); SS[((size_t)u.pm * BM + t) * 8 + u.pn] = (p[0] + p[1]) + (p[2] + p[3]); }
        }
    }
};
template <bool P> struct EpiNull {
    static constexpr bool PERM = P, MIDSCALE = false; typedef PreNone Pre;
    __device__ __forceinline__ void panel_setup(const Unit&, int, int) const {}
    __device__ __forceinline__ Pre pre_load(const Unit&, int) const { return Pre{}; }
    __device__ __forceinline__ void operator()(f32x4 (&acc)[2][2][4][2], const Unit&, const Pre&, int, int, int, int, int) const {
#pragma unroll
        for (int ai = 0; ai < 2; ++ai)
#pragma unroll
            for (int bj = 0; bj < 2; ++bj) asm volatile("" :: "v"(acc[ai][bj][0][0]), "v"(acc[ai][bj][0][1]), "v"(acc[ai][bj][1][0]), "v"(acc[ai][bj][1][1]), "v"(acc[ai][bj][2][0]), "v"(acc[ai][bj][2][1]), "v"(acc[ai][bj][3][0]), "v"(acc[ai][bj][3][1]));
    }
};
struct EpiWin {
    static constexpr bool PERM = true, MIDSCALE = false; typedef PreSS Pre;
    __device__ __forceinline__ void panel_setup(const Unit&, int, int) const {}
    bf16_t* CQKV; bf16_t* NQKV; bf16_t* KR; float* SSQ4; const float* SS; const float* cb; const float* cosT;
    __device__ __forceinline__ Pre pre_load(const Unit& u, int tid) const { return ss_pre_load(SS, u, tid); }
    __device__ __forceinline__ void operator()(f32x4 (&acc)[2][2][4][2], const Unit& u, const Pre& pre, int prev_pm, int wr, int wc, int fr, int fq) const {
        const int row0 = u.pm * BM + wr * 64 + fr;
        const int b = (u.pm < ML / BM) ? (u.pm >> 3) : 16;
        const float* cp = cb + (size_t)b * PINP + u.pn * BM + wc * 32 + 8 * fq;
        f32x4 cv[2][2];
#pragma unroll
        for (int bj = 0; bj < 2; ++bj)
#pragma unroll
            for (int n = 0; n < 2; ++n) cv[bj][n] = *(const f32x4*)(cp + bj * HALF + 4 * n);
        bf16_t* base = CQKV; int colt = u.pn * BM;
        if (u.pn >= 4) { const int t = (u.pn - 4) >> 2; base = NQKV + (size_t)t * MT * 1024; colt = ((u.pn - 4) & 3) * BM; }
        const int col0 = colt + wc * 32 + 8 * fq;
        float rinv[8]; rinv_from_pre(pre, u.pm != prev_pm, wr, wc, fr, fq, rinv);
        LAS float* sq = (LAS float*)(uintptr_t)(SSL_OFF + 4096);
#pragma unroll
        for (int ai = 0; ai < 2; ++ai)
#pragma unroll
            for (int m = 0; m < 4; ++m) { const int row = row0 + ai * HALF + m * 16;
                const float ri = rinv[ai * 4 + m];
                if (u.pn < 16) { bf16_t* rowp = base + (size_t)row * 1024 + col0; float ssq = 0.f;
#pragma unroll
                    for (int bj = 0; bj < 2; ++bj) { const f32x4 v0 = acc[ai][bj][m][0] * ri + cv[bj][0], v1 = acc[ai][bj][m][1] * ri + cv[bj][1];
                        ssq += ((v0[0] * v0[0] + v0[1] * v0[1]) + (v0[2] * v0[2] + v0[3] * v0[3])) + ((v1[0] * v1[0] + v1[1] * v1[1]) + (v1[2] * v1[2] + v1[3] * v1[3]));
                        u32x4 w; w.x = cvt_pk_bf16(v0[0], v0[1]); w.y = cvt_pk_bf16(v0[2], v0[3]); w.z = cvt_pk_bf16(v1[0], v1[1]); w.w = cvt_pk_bf16(v1[2], v1[3]);
                        *(u32x4*)(rowp + bj * HALF) = w; }
                    if (u.pn < 4) { ssq += shfl_xor_f(ssq, 16, fq * 16 + fr); ssq += shfl_xor_f(ssq, 32, fq * 16 + fr); if (fq == 0) sq[(wr * 64 + fr + ai * HALF + m * 16) * 4 + wc] = ssq; }
                } else if (wc < 2) {
                    f32x4 a = acc[ai][0][m][0] * ri + cv[0][0], bq = acc[ai][0][m][1] * ri + cv[0][1];
                    if (u.pm < ML / BM) { const int t = row & (SEQ - 1); const int pos = wc ? (t & 63) : (t >> 6);
                        const f32x4 cs = *(const f32x4*)(cosT + pos * 16 + 4 * fq), sn = *(const f32x4*)(cosT + 1024 + pos * 16 + 4 * fq);
                        const f32x4 a2 = a * cs - bq * sn, b2 = a * sn + bq * cs; a = a2; bq = b2; }
                    u32x4 w; w.x = cvt_pk_bf16(a[0], a[1]); w.y = cvt_pk_bf16(a[2], a[3]); w.z = cvt_pk_bf16(bq[0], bq[1]); w.w = cvt_pk_bf16(bq[2], bq[3]);
                    *(u32x4*)(KR + (size_t)row * 64 + wc * 32 + 8 * fq) = w; }
            }
        if (u.pn < 4) {
            asm volatile("s_waitcnt lgkmcnt(0)" ::: "memory"); __builtin_amdgcn_s_barrier(); asm volatile("" ::: "memory");
            const int t = (wr * 4 + wc) * 64 + fq * 16 + fr;
            if (t < BM) { const f32x4 p = *(const LAS f32x4*)(sq + t * 4); SSQ4[((size_t)u.pm * BM + t) * 4 + u.pn] = (p[0] + p[1]) + (p[2] + p[3]); }
        }
    }
};
struct EpiUp {
    static constexpr bool PERM = true, MIDSCALE = false; typedef PreNone Pre;
    __device__ __forceinline__ void panel_setup(const Unit&, int, int) const {}
    bf16_t* Q; bf16_t* KV; const float* SSQ4; const float* cosT; const float* sinT;
    __device__ __forceinline__ Pre pre_load(const Unit&, int) const { return Pre{}; }
    __device__ __forceinline__ void operator()(f32x4 (&acc)[2][2][4][2], const Unit& u, const Pre&, int, int wr, int wc, int fr, int fq) const {
        const int row0 = u.pm * BM + wr * 64 + fr;
        const bool isq = u.pn < 6; const bool lat = u.pm < ML / BM;
        bf16_t* base = isq ? Q : KV; const int ld = isq ? QW : KVW; const int colt = isq ? u.pn * BM : (u.pn - 6) * BM;
        const int col0 = colt + wc * 32 + 8 * fq;
#pragma unroll
        for (int ai = 0; ai < 2; ++ai)
#pragma unroll
            for (int m = 0; m < 4; ++m) { const int row = row0 + ai * HALF + m * 16; const f32x2 sq2 = *(const f32x2*)(SSQ4 + (size_t)row * 4 + (isq ? 0 : 2)); const float ri = __builtin_amdgcn_rsqf((sq2[0] + sq2[1]) * (1.0f / 512.f) + EPS);
                bf16_t* rowp = base + (size_t)row * ld + col0;
#pragma unroll
                for (int bj = 0; bj < 2; ++bj) { f32x4 v0 = acc[ai][bj][m][0] * ri, v1 = acc[ai][bj][m][1] * ri;
                    const int c32 = (u.pn * 8 + bj * 4 + wc) % 6;
                    if (isq && lat && c32 >= 4) { const int t = row & (SEQ - 1); const int pos = (c32 == 4) ? (t >> 6) : (t & 63);
                        const f32x4 cs = *(const f32x4*)(cosT + pos * 16 + 4 * fq), sn = *(const f32x4*)(sinT + pos * 16 + 4 * fq);
                        const f32x4 a = v0, b = v1; v0 = a * cs - b * sn; v1 = a * sn + b * cs; }
                    u32x4 w; w.x = cvt_pk_bf16(v0[0], v0[1]); w.y = cvt_pk_bf16(v0[2], v0[3]); w.z = cvt_pk_bf16(v1[0], v1[1]); w.w = cvt_pk_bf16(v1[2], v1[3]);
                    *(u32x4*)(rowp + bj * HALF) = w; } }
    }
};
}

namespace att {
constexpr int KN_B = 16384, KR_B = 8192, V_B = 16384, SLOT = KN_B + KR_B + V_B, NSLOT = 3;
constexpr int KN_OFF = 0, KR_OFF = KN_B, V_OFF = KN_B + KR_B;
constexpr int SCR_OFF = NSLOT * SLOT;
constexpr int BIAS_OFF = SCR_OFF + 2048;
constexpr int OST_OFF = BIAS_OFF + 2048;
static_assert(OST_OFF + 8 * 2048 <= LDSCTL_OFF, "attention LDS");
constexpr float THR = 8.f;
#define SBAR() __builtin_amdgcn_sched_barrier(0)
__device__ __forceinline__ int crow(int r, int hi) { return (r & 3) + 8 * (r >> 2) + 4 * hi; }

__device__ __forceinline__ void partialSM(f32x16& p0, f32x16& p1, float& m_reg, float& mn, float& alpha, const float C, const float thr) {
    float pmax = p0[0];
#pragma unroll
    for (int r = 1; r < 16; ++r) pmax = fmaxf(pmax, p0[r]);
#pragma unroll
    for (int r = 0; r < 16; ++r) pmax = fmaxf(pmax, p1[r]);
    { auto rr = __builtin_amdgcn_permlane32_swap(__float_as_uint(pmax), __float_as_uint(pmax), false, false);
      pmax = fmaxf(__uint_as_float(rr[0]), __uint_as_float(rr[1])); }
    if (__builtin_expect(__all(pmax - m_reg <= thr), 1)) { mn = m_reg; alpha = 1.f; }
    else { mn = fmaxf(m_reg, pmax); alpha = __builtin_amdgcn_exp2f((m_reg - mn) * C); m_reg = mn; }
    const float mnC = -mn * C;
#pragma unroll
    for (int r = 0; r < 16; ++r) p0[r] = __builtin_amdgcn_exp2f(fmaf(p0[r], C, mnC));
#pragma unroll
    for (int r = 0; r < 16; ++r) p1[r] = __builtin_amdgcn_exp2f(fmaf(p1[r], C, mnC));
}
__device__ __forceinline__ void finishSM(const f32x16& p0, const f32x16& p1, float alpha, float& l_reg, bf16x8& pa0, bf16x8& pa1, bf16x8& pa2, bf16x8& pa3) {
    float ps = 0;
#pragma unroll
    for (int r = 0; r < 16; ++r) ps += p0[r];
#pragma unroll
    for (int r = 0; r < 16; ++r) ps += p1[r];
    { auto rr = __builtin_amdgcn_permlane32_swap(__float_as_uint(ps), __float_as_uint(ps), false, false);
      ps = __uint_as_float(rr[0]) + __uint_as_float(rr[1]); }
    l_reg = l_reg * alpha + ps;
#define PK4(P, BASE, OUT) do { unsigned a0 = cvt_pk_bf16(P[BASE + 0], P[BASE + 1]), a1 = cvt_pk_bf16(P[BASE + 2], P[BASE + 3]);   \
    unsigned b0 = cvt_pk_bf16(P[BASE + 4], P[BASE + 5]), b1 = cvt_pk_bf16(P[BASE + 6], P[BASE + 7]);                              \
    auto r0 = __builtin_amdgcn_permlane32_swap(a0, b0, false, false); auto r1 = __builtin_amdgcn_permlane32_swap(a1, b1, false, false); \
    u32x4 w = {r0[0], r1[0], r0[1], r1[1]}; OUT = __builtin_bit_cast(bf16x8, w); } while (0)
    PK4(p0, 0, pa0); PK4(p0, 8, pa1); PK4(p1, 0, pa2); PK4(p1, 8, pa3);
#undef PK4
}
__device__ __forceinline__ int v_rd_base(int lane) { return ((lane & 3) << 3) | (((lane >> 2) & 3) << 6) | (((lane >> 4) & 1) << 5) | (((lane >> 5) & 1) << 8); }
constexpr int v_rd_off(int d0, int ks, int half) { return d0 * 512 + ks * 4096 + half * 2048; }
template <int OFF> __device__ __forceinline__ s16x4 tr_read(unsigned vb) {
    s16x4 r; asm volatile("ds_read_b64_tr_b16 %0, %1 offset:%2" : "=&v"(r) : "v"(vb), "i"(OFF) : "memory"); return r;
}
template <int D0> __device__ __forceinline__ void pv_one(f32x16& od, unsigned vb, bf16x8 pa0, bf16x8 pa1, bf16x8 pa2, bf16x8 pa3) {
    const s16x4 l0 = tr_read<v_rd_off(D0, 0, 0)>(vb), h0 = tr_read<v_rd_off(D0, 0, 1)>(vb), l1 = tr_read<v_rd_off(D0, 1, 0)>(vb), h1 = tr_read<v_rd_off(D0, 1, 1)>(vb);
    const s16x4 l2 = tr_read<v_rd_off(D0, 2, 0)>(vb), h2 = tr_read<v_rd_off(D0, 2, 1)>(vb), l3 = tr_read<v_rd_off(D0, 3, 0)>(vb), h3 = tr_read<v_rd_off(D0, 3, 1)>(vb);
    asm volatile("s_waitcnt lgkmcnt(0)" ::: "memory"); SBAR();
#define PK(L, H) (bf16x8){L[0], L[1], L[2], L[3], H[0], H[1], H[2], H[3]}
    od = __builtin_amdgcn_mfma_f32_32x32x16_bf16(pa0, PK(l0, h0), od, 0, 0, 0);
    od = __builtin_amdgcn_mfma_f32_32x32x16_bf16(pa1, PK(l1, h1), od, 0, 0, 0);
    od = __builtin_amdgcn_mfma_f32_32x32x16_bf16(pa2, PK(l2, h2), od, 0, 0, 0);
    od = __builtin_amdgcn_mfma_f32_32x32x16_bf16(pa3, PK(l3, h3), od, 0, 0, 0);
#undef PK
}
__device__ __forceinline__ int swap23(int k) { return (k & ~0xC) | ((k & 4) << 1) | ((k & 8) >> 1); }

template <int DQK, bool NA>
__device__ __forceinline__ void attn_unit(LAS unsigned char* lds, const int wave,
        const bf16_t* __restrict__ Qp, const int ldq, const bf16_t* __restrict__ Knb, const bf16_t* __restrict__ Vb, const int ldkv, const bf16_t* __restrict__ Krb,
        const int base1, const int n1, const int base2, const int n2, const float scale, bf16_t* __restrict__ Op, const int ldo,
        const float* __restrict__ rpb_h, const int strip0, const int qgr0, float* __restrict__ ssa  ) {
    constexpr int ND = DQK / 16;
    const int tid = opaque_tid(wave), lane = tid & 63, wid = __builtin_amdgcn_readfirstlane(tid >> 6);
    const int r32 = lane & 31, hi = lane >> 5;
    LAS float* wsf = (LAS float*)(lds + SCR_OFF) + wid * 64; LAS float* li_l = wsf; LAS float* al_l = wsf + 32;
    LAS float* bias_l = (LAS float*)(lds + BIAS_OFF);
    unsigned okn[2], ov[2], okr;
#pragma unroll
    for (int i = 0; i < 2; ++i) { const int q = i * 512 + tid; const int row = q >> 4, cs = q & 15; okn[i] = (unsigned)(row * ldkv * 2 + ((cs ^ (row & 15)) << 4)); }
#pragma unroll
    for (int i = 0; i < 2; ++i) { const int q = i * 512 + tid; const int sub = q >> 5; const int kk = (sub >> 2) * 8 + ((q & 31) >> 2), c = (sub & 3) * 32 + (q & 3) * 8; ov[i] = (unsigned)(swap23(kk) * ldkv * 2 + c * 2); }
    { const int q = tid; const int row = q >> 3, cs = q & 7; okr = (unsigned)(row * 128 + ((cs ^ ((row >> 1) & 7)) << 4)); }
    const int nt = n1 + n2;
    __syncthreads();
    if (NA) { for (int i = tid; i < 465; i += 512) bias_l[i] = rpb_h[i]; }
    bf16x8 qr[ND];
    { const bf16_t* Qw = Qp + (size_t)(wid * 32 + r32) * ldq + hi * 8;
#pragma unroll
      for (int d0 = 0; d0 < ND; ++d0) qr[d0] = *(const bf16x8*)(Qw + d0 * 16); }
#define ATT_TROW(j_) ((j_) < n1 ? base1 + 64 * (j_) : base2 + 64 * ((j_) - n1))
#define ATT_ISSUE(j_, slot_) do { const size_t tr_ = (size_t)ATT_TROW(j_); LAS unsigned char* sl_ = lds + (slot_) * SLOT + wid * 1024; \
        const char* kb_ = (const char*)Knb + tr_ * (size_t)ldkv * 2; const char* vb_ = (const char*)Vb + tr_ * (size_t)ldkv * 2; \
        __builtin_amdgcn_global_load_lds((const unsigned*)(kb_ + okn[0]), (LAS unsigned*)(sl_ + KN_OFF), 16, 0, 0); \
        __builtin_amdgcn_global_load_lds((const unsigned*)(kb_ + okn[1]), (LAS unsigned*)(sl_ + KN_OFF + 8192), 16, 0, 0); \
        __builtin_amdgcn_global_load_lds((const unsigned*)(vb_ + ov[0]), (LAS unsigned*)(sl_ + V_OFF), 16, 0, 0); \
        __builtin_amdgcn_global_load_lds((const unsigned*)(vb_ + ov[1]), (LAS unsigned*)(sl_ + V_OFF + 8192), 16, 0, 0); \
        if (DQK == 192) __builtin_amdgcn_global_load_lds((const unsigned*)((const char*)Krb + tr_ * 128 + okr), (LAS unsigned*)(sl_ + KR_OFF), 16, 0, 0); } while (0)
    if (NA) { ATT_ISSUE(0, 0); if (nt > 1) ATT_ISSUE(1, 1); } else { ATT_ISSUE(0, 0); }
    float m_reg = -1e30f, l_reg = 0.f;
    f32x16 o[4];
#pragma unroll
    for (int d = 0; d < 4; ++d)
#pragma unroll
        for (int r = 0; r < 16; ++r) o[d][r] = 0.f;
    const int gr = qgr0 + (wid >> 1), rs = min(max(gr - 4, 0), 24);
    const int qc = (wid & 1) * 32 + r32, cs0 = min(max(qc - 8, 0), 48);
    const unsigned lds_u = (unsigned)(unsigned long)lds;
    if constexpr (!NA) {
        const float C = scale * 1.4426950408889634f, thr = THR / scale;
        f32x16 pA0, pA1, pB0, pB1; float alA = 1.f, alB = 1.f, mnT;
#define T15_QK(sb_, P0, P1) do { \
            _Pragma("unroll") for (int r = 0; r < 16; ++r) { P0[r] = 0.f; P1[r] = 0.f; } \
            bf16x8 kf0[2], kf1[2]; \
            const unsigned ka = (sb_) + KN_OFF + r32 * 256, kx = (unsigned)((r32 & 15) << 4); \
            const unsigned ra = (sb_) + KR_OFF + r32 * 128, rx = (unsigned)((r32 >> 1) & 7); \
            kf0[0] = *(const LAS bf16x8*)(ka + ((unsigned)(hi * 16) ^ kx)); kf1[0] = *(const LAS bf16x8*)(ka + 32 * 256 + ((unsigned)(hi * 16) ^ kx)); \
            _Pragma("unroll") for (int d0 = 0; d0 < ND; ++d0) { \
                if (d0 + 1 < 8) { const unsigned cb = (unsigned)(((d0 + 1) * 16 + hi * 8) * 2) ^ kx; kf0[(d0 + 1) & 1] = *(const LAS bf16x8*)(ka + cb); kf1[(d0 + 1) & 1] = *(const LAS bf16x8*)(ka + 32 * 256 + cb); } \
                else if (d0 + 1 < ND) { const unsigned ch = ((unsigned)((d0 + 1 - 8) * 2 + hi) ^ rx) << 4; kf0[(d0 + 1) & 1] = *(const LAS bf16x8*)(ra + ch); kf1[(d0 + 1) & 1] = *(const LAS bf16x8*)(ra + 32 * 128 + ch); } \
                P0 = __builtin_amdgcn_mfma_f32_32x32x16_bf16(kf0[d0 & 1], qr[d0], P0, 0, 0, 0); \
                P1 = __builtin_amdgcn_mfma_f32_32x32x16_bf16(kf1[d0 & 1], qr[d0], P1, 0, 0, 0); } } while (0)
#define T15_RESC(a_) do { if (__any((a_) < 1.f)) { if (hi == 0) al_l[r32] = (a_); asm volatile("s_waitcnt lgkmcnt(0)" ::: "memory"); \
            _Pragma("unroll") for (int r = 0; r < 16; ++r) { const float a = al_l[crow(r, hi)]; _Pragma("unroll") for (int d = 0; d < 4; ++d) o[d][r] *= a; } } } while (0)
#define T15_TOP(j_, sn_) do { asm volatile("s_waitcnt vmcnt(0)" ::: "memory"); asm volatile("s_waitcnt lgkmcnt(0)" ::: "memory"); __builtin_amdgcn_s_barrier(); asm volatile("" ::: "memory"); \
            if ((j_) + 1 < nt) ATT_ISSUE((j_) + 1, sn_); } while (0)
#define T15_STEP(j_, sc_, so_, sn_, PN0, PN1, AN, PO0, PO1, AO) do { \
            T15_TOP(j_, sn_); \
            bf16x8 pa0, pa1, pa2, pa3; \
            SBAR(); T15_QK(lds_u + (sc_) * SLOT, PN0, PN1); finishSM(PO0, PO1, AO, l_reg, pa0, pa1, pa2, pa3); SBAR(); \
            { const unsigned vb = lds_u + (so_) * SLOT + V_OFF + v_rd_base(lane); \
              pv_one<0>(o[0], vb, pa0, pa1, pa2, pa3); pv_one<1>(o[1], vb, pa0, pa1, pa2, pa3); pv_one<2>(o[2], vb, pa0, pa1, pa2, pa3); pv_one<3>(o[3], vb, pa0, pa1, pa2, pa3); } \
            partialSM(PN0, PN1, m_reg, mnT, AN, C, thr); \
            T15_RESC(AN); } while (0)
        T15_TOP(0, 1);
        T15_QK(lds_u, pA0, pA1); partialSM(pA0, pA1, m_reg, mnT, alA, C, thr); T15_RESC(alA);
        int sc = 1, so = 0, sn = 2;
        for (int j = 1; j < nt; j += 2) {
            T15_STEP(j, sc, so, sn, pB0, pB1, alB, pA0, pA1, alA);
            { const int t = so; so = sc; sc = sn; sn = t; }
            if (j + 1 < nt) {
                T15_STEP(j + 1, sc, so, sn, pA0, pA1, alA, pB0, pB1, alB);
                { const int t = so; so = sc; sc = sn; sn = t; }
            }
        }
        {
            bf16x8 pa0, pa1, pa2, pa3;
            if ((nt & 1) == 0) finishSM(pB0, pB1, alB, l_reg, pa0, pa1, pa2, pa3); else finishSM(pA0, pA1, alA, l_reg, pa0, pa1, pa2, pa3);
            const unsigned vb = lds_u + so * SLOT + V_OFF + v_rd_base(lane);
            pv_one<0>(o[0], vb, pa0, pa1, pa2, pa3); pv_one<1>(o[1], vb, pa0, pa1, pa2, pa3); pv_one<2>(o[2], vb, pa0, pa1, pa2, pa3); pv_one<3>(o[3], vb, pa0, pa1, pa2, pa3);
        }
#undef T15_QK
#undef T15_RESC
#undef T15_TOP
#undef T15_STEP
    } else {
    int slot = 0, slot2 = 2;
    for (int j = 0; j < nt; ++j) {
        if (j + 1 < nt) { if (DQK == 192) asm volatile("s_waitcnt vmcnt(5)" ::: "memory"); else asm volatile("s_waitcnt vmcnt(4)" ::: "memory"); }
        else asm volatile("s_waitcnt vmcnt(0)" ::: "memory");
        asm volatile("s_waitcnt lgkmcnt(0)" ::: "memory");
        __builtin_amdgcn_s_barrier();
        asm volatile("" ::: "memory");
        if (j + 2 < nt) ATT_ISSUE(j + 2, slot2);
        bool active = true; int dr = 0;
        if (NA && j < n1) { const int kr = strip0 + j; active = (kr >= rs) && (kr < rs + 8); dr = kr - gr + 7; }
        if (active) {
            const unsigned sb = lds_u + slot * SLOT;
            f32x16 p0, p1;
#pragma unroll
            for (int r = 0; r < 16; ++r) { p0[r] = 0.f; p1[r] = 0.f; }
            {
                bf16x8 kf0[2], kf1[2];
                const unsigned ka = sb + KN_OFF + r32 * 256, kx = (unsigned)((r32 & 15) << 4);
                const unsigned ra = sb + KR_OFF + r32 * 128, rx = (unsigned)((r32 >> 1) & 7);
                kf0[0] = *(const LAS bf16x8*)(ka + ((unsigned)(hi * 16) ^ kx)); kf1[0] = *(const LAS bf16x8*)(ka + 32 * 256 + ((unsigned)(hi * 16) ^ kx));
#pragma unroll
                for (int d0 = 0; d0 < ND; ++d0) {
                    if (d0 + 1 < 8) { const unsigned cb = (unsigned)(((d0 + 1) * 16 + hi * 8) * 2) ^ kx; kf0[(d0 + 1) & 1] = *(const LAS bf16x8*)(ka + cb); kf1[(d0 + 1) & 1] = *(const LAS bf16x8*)(ka + 32 * 256 + cb); }
                    else if (d0 + 1 < ND) { const unsigned ch = ((unsigned)((d0 + 1 - 8) * 2 + hi) ^ rx) << 4; kf0[(d0 + 1) & 1] = *(const LAS bf16x8*)(ra + ch); kf1[(d0 + 1) & 1] = *(const LAS bf16x8*)(ra + 32 * 128 + ch); }
                    p0 = __builtin_amdgcn_mfma_f32_32x32x16_bf16(kf0[d0 & 1], qr[d0], p0, 0, 0, 0);
                    p1 = __builtin_amdgcn_mfma_f32_32x32x16_bf16(kf1[d0 & 1], qr[d0], p1, 0, 0, 0);
                }
            }
            float mn, alpha;
            if (NA) {
                if (j < n1) {
                    const LAS float* brow = bias_l + dr * 31 - qc + 15;
#pragma unroll
                    for (int r = 0; r < 16; ++r) { const int kc = crow(r, hi); const bool v0 = (unsigned)(kc - cs0) < 16u, v1 = (unsigned)(kc + 32 - cs0) < 16u;
                        const float b0 = brow[v0 ? kc : qc], b1 = brow[v1 ? kc + 32 : qc];
                        p0[r] = v0 ? fmaf(p0[r], scale, b0) : -1e30f; p1[r] = v1 ? fmaf(p1[r], scale, b1) : -1e30f; }
                } else {
#pragma unroll
                    for (int r = 0; r < 16; ++r) { p0[r] *= scale; p1[r] *= scale; }
                }
                partialSM(p0, p1, m_reg, mn, alpha, 1.4426950408889634f, THR);
            } else {
                partialSM(p0, p1, m_reg, mn, alpha, scale * 1.4426950408889634f, THR / scale);
            }
            if (__any(alpha < 1.f)) { if (hi == 0) al_l[r32] = alpha; asm volatile("s_waitcnt lgkmcnt(0)" ::: "memory");
#pragma unroll
                for (int r = 0; r < 16; ++r) { const float a = al_l[crow(r, hi)];
#pragma unroll
                    for (int d = 0; d < 4; ++d) o[d][r] *= a; } }
            bf16x8 pa0, pa1, pa2, pa3;
            finishSM(p0, p1, alpha, l_reg, pa0, pa1, pa2, pa3);
            const unsigned vb = sb + V_OFF + v_rd_base(lane);
            pv_one<0>(o[0], vb, pa0, pa1, pa2, pa3); pv_one<1>(o[1], vb, pa0, pa1, pa2, pa3); pv_one<2>(o[2], vb, pa0, pa1, pa2, pa3); pv_one<3>(o[3], vb, pa0, pa1, pa2, pa3);
        }
        slot = (slot == 2) ? 0 : slot + 1; slot2 = (slot2 == 2) ? 0 : slot2 + 1;
    }
    }
    if (hi == 0) li_l[r32] = l_reg; asm volatile("s_waitcnt lgkmcnt(0)" ::: "memory");
    LAS unsigned char* ost = lds + OST_OFF + wid * 2048;
    bf16_t* Ow = Op + (size_t)(wid * 32) * ldo;
#pragma unroll
    for (int g = 0; g < 4; ++g) {
#pragma unroll
        for (int rr = 0; rr < 4; ++rr) { const int r = 4 * g + rr; const int orow = crow(r, hi); const float rl = __builtin_amdgcn_rcpf(li_l[orow]);
#pragma unroll
            for (int d0 = 0; d0 < 4; ++d0) *(LAS bf16_t*)(ost + ((orow & 7) * 128 + d0 * 32 + r32) * 2) = (bf16_t)f2bf(o[d0][r] * rl); }
        asm volatile("s_waitcnt lgkmcnt(0)" ::: "memory");
#pragma unroll
        for (int h = 0; h < 2; ++h) { const int ch = lane + 64 * h; const u32x4 v = *(const LAS u32x4*)(ost + ch * 16);
            *(u32x4*)(Ow + (size_t)(8 * g + (ch >> 4)) * ldo + (ch & 15) * 8) = v;
            float sq = 0.f;
#pragma unroll
            for (int i = 0; i < 4; ++i) { const float x0 = bf2f(v[i] & 0xffffu), x1 = bf2f(v[i] >> 16); sq += x0 * x0 + x1 * x1; }
            sq += shfl_xor_f(sq, 1, lane); sq += shfl_xor_f(sq, 2, lane); sq += shfl_xor_f(sq, 4, lane); sq += shfl_xor_f(sq, 8, lane);
            if ((ch & 15) == 0) ssa[(size_t)(wid * 32 + 8 * g + (ch >> 4)) * 16] = sq; }
        asm volatile("s_waitcnt lgkmcnt(0)" ::: "memory");
    }
#undef ATT_TROW
#undef ATT_ISSUE
}
}

#define XB_TMO      128
#define XB_XCNT(j)  (256  + 64 * (j))
#define XB_XSUB(j)  (1280 + 64 * (j))
#define XB_XGEN(j)  (2304 + 64 * (j))
#define XB_TOP      3328
#define XB_TOPGEN   3392
#define XCD_BAR_WORDS 3456
#define XB_SPIN_CAP (1u << 18)
__device__ __forceinline__ unsigned xb_ld(unsigned* p)              { return __hip_atomic_load(p, __ATOMIC_RELAXED, __HIP_MEMORY_SCOPE_AGENT); }
__device__ __forceinline__ unsigned xb_add(unsigned* p, unsigned v) { return __hip_atomic_fetch_add(p, v, __ATOMIC_RELAXED, __HIP_MEMORY_SCOPE_AGENT); }
__device__ __forceinline__ unsigned xb_xcc_id() { return (unsigned)__builtin_amdgcn_s_getreg((3 << 11) | 20) & 0xFu; }
#define XB_SPIN(cond, bar) do { unsigned _sp = 0; while (cond) { __builtin_amdgcn_s_sleep(1); \
    if ((++_sp & 255u) == 0u) { if (xb_ld(&(bar)[XB_TMO])) break; if (_sp > XB_SPIN_CAP) { atomicAdd(&(bar)[XB_TMO], 1u); break; } } } } while (0)
struct XcdBarrier { unsigned* bar; unsigned x; volatile LAS unsigned* st; int wave; };
__device__ __forceinline__ XcdBarrier xcd_barrier_post(unsigned* bar, volatile LAS unsigned* st) {
    XcdBarrier b; b.bar = bar; b.x = xb_xcc_id(); b.st = st; b.wave = 0;
    if (threadIdx.x == 0) (void)xb_add(&bar[XB_XCNT(b.x)], 1u);
    return b;
}
__device__ __forceinline__ void xcd_barrier_complete(unsigned* bar, unsigned x, unsigned& nloc, unsigned& nx) {
    const unsigned G = gridDim.x * gridDim.y * gridDim.z;
    unsigned sum, cnt, mine, sp = 0u;
    for (;;) {
        sum = 0u; cnt = 0u; mine = 0u;
#pragma unroll
        for (unsigned j = 0; j < 16; ++j) { const unsigned c = xb_ld(&bar[XB_XCNT(j)]); sum += c; cnt += (c > 0u) ? 1u : 0u; mine = (j == x) ? c : mine; }
        if (sum == G) break;
        __builtin_amdgcn_s_sleep(1);
        if ((++sp & 255u) == 0u) { if (xb_ld(&bar[XB_TMO])) break; if (sp > XB_SPIN_CAP) { atomicAdd(&bar[XB_TMO], 1u); break; } }
    }
    nloc = mine > 0u ? mine : 1u; nx = cnt > 0u ? cnt : 1u;
}
__device__ __forceinline__ void xcd_barrier(const XcdBarrier& b) {
    asm volatile("s_waitcnt vmcnt(0)" ::: "memory");
    __syncthreads();
    if (b.wave == 0 && lane_now() == 0) {
        unsigned* bar = b.bar; unsigned bx_ = b.x; asm volatile("" : "+s"(bar), "+s"(bx_));
        __builtin_amdgcn_s_waitcnt(0);
        unsigned nloc = b.st[0], nx = b.st[1];
        if (nloc == 0u) { xcd_barrier_complete(bar, bx_, nloc, nx); b.st[0] = nloc; b.st[1] = nx; }
        const unsigned old = xb_add(&bar[XB_XSUB(bx_)], 1u);
        const unsigned gen = old / nloc;
        if (old + 1u == (gen + 1u) * nloc) {
            __builtin_amdgcn_fence(__ATOMIC_RELEASE, "agent");
            asm volatile("s_waitcnt vmcnt(0)" ::: "memory");
            const unsigned og = xb_add(&bar[XB_TOP], 1u);
            const unsigned tg = og / nx;
            if (og + 1u == (tg + 1u) * nx) xb_add(&bar[XB_TOPGEN], 1u);
            else XB_SPIN(xb_ld(&bar[XB_TOPGEN]) == tg, bar);
            __builtin_amdgcn_fence(__ATOMIC_ACQUIRE, "agent");
            xb_add(&bar[XB_XGEN(bx_)], 1u);
            asm volatile("s_waitcnt vmcnt(0)" ::: "memory");
        } else {
            XB_SPIN(xb_ld(&bar[XB_XGEN(bx_)]) == gen, bar);
            __builtin_amdgcn_fence(__ATOMIC_ACQUIRE, "agent");
            asm volatile("s_waitcnt vmcnt(0)" ::: "memory");
        }
    }
    __syncthreads();
}

struct Args { const float* in[24]; float* out; unsigned char* ws; int ph_lo, ph_hi; };
enum { I_X = 0, I_C, I_CTX, I_CCTX, I_ADAW, I_ADAB, I_F1N, I_F1W1, I_F1W3, I_F1W2, I_MIXN, I_WIN, I_QAN, I_WUQ, I_KVAN, I_WUKV, I_RPB, I_OUTN, I_WOUT, I_F2N, I_F2W1, I_F2W3, I_F2W2, I_FINN };
struct Frame {
    LAS unsigned char* lds; int wave, vcu, G, bx;
    float* out; unsigned char* ws; const float* x; const float* ctx;
};
__device__ __forceinline__ unsigned char* wl(const Frame& F, int  , size_t off) { return F.ws + WS_W + off; }
__device__ __forceinline__ float* fMOD(const Frame& F) { return (float*)(F.ws + WS_MOD); }
__device__ __forceinline__ bf16_t* fXN(const Frame& F) { return (bf16_t*)(F.ws + WS_XN); }
__device__ __forceinline__ unsigned char* fBIG(const Frame& F) { return F.ws + WS_BIG; }
__device__ __forceinline__ const float* fSM(const Frame& F, int off) { return (const float*)(F.ws + WS_SMALL) + off; }

__device__ __forceinline__ void tr_item(const float* __restrict__ W, int ldw, int k0, int srccol0, bool ropeperm, const float* __restrict__ gain, bool zero,
                                        bf16_t* __restrict__ WT, int ldt, int dstrow0, LAS float* scr, int lane) {
    if (!zero) {
        float v[32];
        const float* wp = W + (size_t)(k0 + (lane >> 5)) * ldw + srccol0 + (lane & 31);
#pragma unroll
        for (int i = 0; i < 32; ++i) v[i] = wp[(size_t)(2 * i) * ldw];
#pragma unroll
        for (int i = 0; i < 32; ++i) scr[(2 * i + (lane >> 5)) * 33 + (lane & 31)] = v[i];
    }
    LDS_WAIT(); asm volatile("" ::: "memory");
    const int c = lane & 7;
    float gk[8];
#pragma unroll
    for (int q = 0; q < 8; ++q) gk[q] = gain ? gain[k0 + 8 * c + q] : 1.0f;
#pragma unroll
    for (int j = 0; j < 4; ++j) { const int n = (lane >> 3) + 8 * j; const int sn = ropeperm ? (((n >> 2) & 1) * 16 + (n >> 3) * 4 + (n & 3)) : n;
        const LAS float* s = scr + (8 * c) * 33 + sn;
        u32x4 o;
        if (zero) { unsigned z_ = 0u; asm volatile("" : "+v"(z_)); o = (u32x4){z_, z_, z_, z_}; }
        else { o.x = cvt_pk_bf16(s[0 * 33] * gk[0], s[1 * 33] * gk[1]); o.y = cvt_pk_bf16(s[2 * 33] * gk[2], s[3 * 33] * gk[3]); o.z = cvt_pk_bf16(s[4 * 33] * gk[4], s[5 * 33] * gk[5]); o.w = cvt_pk_bf16(s[6 * 33] * gk[6], s[7 * 33] * gk[7]); }
        *(u32x4*)(WT + (size_t)(dstrow0 + n) * ldt + k0 + 8 * c) = o; }
    LDS_WAIT(); asm volatile("" ::: "memory");
}
__device__ __forceinline__ void convert_range(Frame& F, const float* const* in, const int l, const int it_lo, const int it_hi, const int gw, const int NGW);
__device__ __forceinline__ void p0_prologue(Frame& F, const float* const* in) {
    const int tid_ = opaque_tid(F.wave), lane_ = tid_ & 63; (void)tid_; (void)lane_;
    {
        LAS float* SC = (LAS float*)F.lds;
        for (int i = tid_; i < 17 * D; i += 512) { const int r = i >> 11, k = i & (D - 1); const float v = (r < 16) ? in[I_C][r * D + k] : in[I_CCTX][k]; SC[i] = silu_f(v); }
        __syncthreads();
        for (int item = F.bx; item < 256; item += F.G) {
            const int l = item >> 7, n0 = (item & 127) * 144;
            const float* W = in[I_ADAW] + (size_t)l * D * NMOD + n0 + 4 * lane_;
            f32x4 acc[17];
#pragma unroll
            for (int r = 0; r < 17; ++r) acc[r] = (f32x4){0.f, 0.f, 0.f, 0.f};
            const int kb = F.wave * 256;
            if (lane_ < 36) {
                for (int kk = 0; kk < 256; kk += 8) {
                    f32x4 w[8];
#pragma unroll
                    for (int q = 0; q < 8; ++q) w[q] = *(const f32x4*)(W + (size_t)(kb + kk + q) * NMOD);
#pragma unroll
                    for (int r = 0; r < 17; ++r) { const f32x4 s = *(const LAS f32x4*)(SC + r * D + kb + kk), s2 = *(const LAS f32x4*)(SC + r * D + kb + kk + 4);
                        acc[r] += w[0] * s[0]; acc[r] += w[1] * s[1]; acc[r] += w[2] * s[2]; acc[r] += w[3] * s[3];
                        acc[r] += w[4] * s2[0]; acc[r] += w[5] * s2[1]; acc[r] += w[6] * s2[2]; acc[r] += w[7] * s2[3]; }
                }
            }
            __syncthreads();
            LAS float* PT = (LAS float*)F.lds;
            LAS float* PT2 = (LAS float*)(F.lds + 0);
            (void)PT2;
            if (lane_ < 36) {
#pragma unroll
                for (int r = 0; r < 17; ++r) *(LAS f32x4*)(PT + (F.wave * 17 + r) * 144 + 4 * lane_) = acc[r];
            }
            __syncthreads();
            for (int i = tid_; i < 17 * 144; i += 512) { const int r = i / 144, cidx = i % 144; float s = in[I_ADAB][l * NMOD + n0 + cidx];
#pragma unroll
                for (int w = 0; w < 8; ++w) s += PT[(w * 17 + r) * 144 + cidx];
                fMOD(F)[((size_t)l * 17 + r) * NMOD + n0 + cidx] = s; }
            __syncthreads();
            if (item + F.G < 256) {
                for (int i = tid_; i < 17 * D; i += 512) { const int r = i >> 11, k = i & (D - 1); const float v = (r < 16) ? in[I_C][r * D + k] : in[I_CCTX][k]; SC[i] = silu_f(v); }
                __syncthreads();
            }
        }
    }
    if (F.bx == 0) {
        float* cosT = (float*)(F.ws + WS_ROPE); float* sinT = cosT + 1024;
        for (int i = tid_; i < 1024; i += 512) { const int pos = i >> 4, f = i & 15; const float inv = powf(10000.f, -(float)f / 16.f); const float ang = (float)pos * inv; cosT[i] = cosf(ang); sinT[i] = sinf(ang); }
    }
    { float* sm = (float*)(F.ws + WS_SMALL);
      for (int i = F.bx * 512 + tid_; i < SM_TOTAL; i += F.G * 512) { float v;
          if (i < SM_MIXN) v = in[I_F1N][i]; else if (i < SM_F2N) v = in[I_MIXN][i - SM_MIXN]; else if (i < SM_OUTN) v = in[I_F2N][i - SM_F2N]; else if (i < SM_FINN) v = in[I_OUTN][i - SM_OUTN];
          else if (i < SM_RPB) v = in[I_FINN][i - SM_FINN]; else v = in[I_RPB][i - SM_RPB];
          sm[i] = v; } }
    __syncthreads();
    convert_range(F, in, 0, 0, CV_ALL, F.vcu * 8 + F.wave, F.G * 8);
}
__device__ __forceinline__ void convert_range(Frame& F, const float* const* in, const int l, const int it_lo, const int it_hi, const int gw, const int NGW) {
    const int tid_ = opaque_tid(F.wave), lane_ = tid_ & 63; (void)tid_;
    __syncthreads();
    LAS float* scr = (LAS float*)(F.lds + F.wave * 16384);
    constexpr int I_13 = CV_I13, I_2 = CV_I2, I_IN = CV_IIN, I_UP = CV_IUP;
    for (int it = it_lo + gw; it < it_hi; it += NGW) {
        int r = it;
        bool done = false;
#pragma unroll
        for (int f = 0; f < 2; ++f) {
            if (!done && r < I_13) {
                const int nblk = 2 * DFF / 32, kb = r / nblk, nb = r % nblk, n0 = nb * 32, pn = n0 >> 8, j = n0 & 255;
                const float* W = (j < 128) ? in[f ? I_F2W1 : I_F1W1] : in[f ? I_F2W3 : I_F1W3];
                tr_item(W + (size_t)l * D * DFF, DFF, kb * 64, pn * 128 + (j & 127), false, nullptr, false, (bf16_t*)wl(F, l, f ? WL_W13B : WL_W13A), D, n0, scr, lane_); done = true; }
            if (!done) r -= I_13;
            if (!done && r < I_2) {
                const int nblk = D / 32, kb = r / nblk, nb = r % nblk;
                tr_item(in[f ? I_F2W2 : I_F1W2] + (size_t)l * DFF * D, D, kb * 64, nb * 32, false, nullptr, false, (bf16_t*)wl(F, l, f ? WL_W2B : WL_W2A), DFF, nb * 32, scr, lane_); done = true; }
            if (!done) r -= I_2;
        }
        if (done) continue;
        if (r < I_IN) {
            const int nblk = PINP / 32, kb = r / nblk, nb = r % nblk, n0 = nb * 32;
            const int src = (n0 < 1024) ? n0 : (n0 < 4096) ? n0 + 64 : (n0 < PIN) ? 1024 + (n0 - 4096) : 0;
            tr_item(in[I_WIN] + (size_t)l * D * PIN, PIN, kb * 64, src, n0 >= 4096 && n0 < PIN  , nullptr, n0 >= PIN, (bf16_t*)wl(F, l, WL_WIN), D, n0, scr, lane_); continue; }
        r -= I_IN;
        if (r < I_UP) {
            const int nblk = UPW / 32, kb = r / nblk, nb = r % nblk, n0 = nb * 32;
            if (n0 < QW) { const int within = n0 % 192;
                tr_item(in[I_WUQ] + (size_t)l * 512 * QW, QW, kb * 64, n0, within >= 128, in[I_QAN] + l * 512, false, (bf16_t*)wl(F, l, WL_WUP), 512, n0, scr, lane_); }
            else tr_item(in[I_WUKV] + (size_t)l * 512 * KVW, KVW, kb * 64, n0 - QW, false, in[I_KVAN] + l * 512, false, (bf16_t*)wl(F, l, WL_WUP), 512, n0, scr, lane_);
            continue; }
        r -= I_UP;
        { const int nblk = D / 32, kb = r / nblk, nb = r % nblk;
          tr_item(in[I_WOUT] + (size_t)l * D * D, D, kb * 64, nb * 32, false, in[I_OUTN] + l * D  , false, (bf16_t*)wl(F, l, WL_WOUT), D, nb * 32, scr, lane_); }
    }
}

__device__ __forceinline__ void cvec_layer(Frame& F, const int l);
__device__ __forceinline__ void init_phase(Frame& F) {
    const int tid_ = opaque_tid(F.wave), lane_ = tid_ & 63; (void)tid_;
    const int gw = F.vcu * 8 + F.wave, NGW = F.G * 8;
    {
        const float* gain = fSM(F, SM_F1N); float* SS = (float*)(F.ws + WS_SS);
        for (int it = gw; it < MT / 4; it += NGW) {
            const int row0 = it * 4; const int b = row0 < ML ? (row0 >> 11) : 16;
            const float* mod = fMOD(F) + (size_t)b * NMOD;
            f32x4 gs[4][2];
#pragma unroll
            for (int j = 0; j < 4; ++j)
#pragma unroll
                for (int h = 0; h < 2; ++h) { const int c = 8 * lane_ + 512 * j + 4 * h; gs[j][h] = *(const f32x4*)(gain + c) * (*(const f32x4*)(mod + 1 * D + c) + 1.0f); }
#pragma unroll 2
            for (int rr = 0; rr < 4; ++rr) { const int row = row0 + rr;
                const float* hp = (row < ML) ? F.x + (size_t)row * D : F.ctx + (size_t)(row - ML) * D;
                f32x4 v[4][2]; float ss = 0.f;
#pragma unroll
                for (int j = 0; j < 4; ++j)
#pragma unroll
                    for (int h = 0; h < 2; ++h) { v[j][h] = *(const f32x4*)(hp + 8 * lane_ + 512 * j + 4 * h); const f32x4 x = v[j][h]; ss += (x[0] * x[0] + x[1] * x[1]) + (x[2] * x[2] + x[3] * x[3]); }
                ss = wave_sum(ss, lane_);
                if (lane_ < 8) SS[(size_t)row * 8 + lane_] = (lane_ == 0) ? ss : 0.f;
                bf16_t* op = fXN(F) + (size_t)row * XNP + 8 * lane_;
                _Float16* hp16 = (_Float16*)(F.ws + WS_H16) + (size_t)row * D + 8 * lane_;
#pragma unroll
                for (int j = 0; j < 4; ++j) { u32x4 hv; hv.x = cvt_pk_f16(v[j][0][0], v[j][0][1]); hv.y = cvt_pk_f16(v[j][0][2], v[j][0][3]); hv.z = cvt_pk_f16(v[j][1][0], v[j][1][1]); hv.w = cvt_pk_f16(v[j][1][2], v[j][1][3]);
                    *(u32x4*)(hp16 + 512 * j) = hv; }
#pragma unroll
                for (int j = 0; j < 4; ++j) { const f32x4 a = v[j][0] * gs[j][0], c = v[j][1] * gs[j][1];
                    u32x4 w; w.x = cvt_pk_bf16(a[0], a[1]); w.y = cvt_pk_bf16(a[2], a[3]); w.z = cvt_pk_bf16(c[0], c[1]); w.w = cvt_pk_bf16(c[2], c[3]);
                    *(u32x4*)(op + 512 * j) = w; }
            }
        }
    }
    cvec_layer(F, 0);
}
__device__ __forceinline__ void cvec_layer(Frame& F, const int l) {
    const int tid_ = opaque_tid(F.wave), lane_ = tid_ & 63;
    const int gw = F.vcu * 8 + F.wave, NGW = F.G * 8;
    constexpr int PITCH = D + 8;
    LAS bf16_t* SHH = (LAS bf16_t*)F.lds; LAS bf16_t* SHL = SHH + 17 * PITCH;
    static_assert(2 * 17 * PITCH * 2 <= LDSCTL_OFF, "cvec_layer LDS");
    int sp, lw, nw;
    { const int w = (F.vcu * 256) / F.G;
      if (w < 108) { sp = 0; lw = w; nw = 108; } else if (w < 148) { sp = 1; lw = w - 108; nw = 40; } else { sp = 2; lw = w - 148; nw = 108; } }
    const bool fullgrid = (F.G == 256);
    for (int pass = 0; pass < (fullgrid ? 1 : 3); ++pass) {
        const int s = fullgrid ? sp : pass;
        const int N = (s == 1) ? PINP : 2 * DFF; const int sidx = 3 * s;
        const bf16_t* Wt = (const bf16_t*)wl(F, l, s == 0 ? WL_W13A : s == 1 ? WL_WIN : WL_W13B);
        float* out = (float*)(F.ws + WS_CB) + (size_t)l * CB_LAYER + (s == 0 ? CB_S0 : s == 1 ? CB_S1 : CB_S2);
        __syncthreads();
        for (int i = tid_; i < 17 * D; i += 512) { const int b = i >> 11, k = i & (D - 1); const float v = fMOD(F)[((size_t)l * 17 + b) * NMOD + sidx * D + k];
            const unsigned hb = f2bf(v); const float lo = v - bf2f(hb); SHH[b * PITCH + k] = (bf16_t)hb; SHL[b * PITCH + k] = (bf16_t)f2bf(lo); }
        __syncthreads();
        const int r32 = lane_ & 31, hi = lane_ >> 5, brow = r32 < 16 ? r32 : 16;
        const int gwl = fullgrid ? lw * 8 + F.wave : gw, ngwl = fullgrid ? nw * 8 : NGW;
        for (int blk = gwl; blk < N / 32; blk += ngwl) {
            const bf16_t* wp = Wt + (size_t)(blk * 32 + r32) * D + hi * 8;
            const LAS bf16_t* ah = SHH + brow * PITCH + hi * 8; const LAS bf16_t* al = SHL + brow * PITCH + hi * 8;
            f32x16 acc;
#pragma unroll
            for (int r = 0; r < 16; ++r) acc[r] = 0.f;
            for (int k0 = 0; k0 < D; k0 += 512) {
                bf16x8 bw[32];
#pragma unroll
                for (int q = 0; q < 32; ++q) bw[q] = *(const bf16x8*)(wp + k0 + 16 * q);
#pragma unroll
                for (int q = 0; q < 32; ++q) { const bf16x8 a0 = *(const LAS bf16x8*)(ah + k0 + 16 * q), a1 = *(const LAS bf16x8*)(al + k0 + 16 * q);
                    acc = __builtin_amdgcn_mfma_f32_32x32x16_bf16(a0, bw[q], acc, 0, 0, 0);
                    acc = __builtin_amdgcn_mfma_f32_32x32x16_bf16(a1, bw[q], acc, 0, 0, 0); }
            }
#pragma unroll
            for (int r = 0; r < 16; ++r) { const int b = (r & 3) + 8 * (r >> 2) + 4 * hi; if (b < 17) out[(size_t)b * N + blk * 32 + r32] = acc[r]; }
        }
    }
}
__device__ __forceinline__ void final_phase(Frame& F) {
    const int tid_ = opaque_tid(F.wave), lane_ = tid_ & 63; (void)tid_;
    const int gw = F.vcu * 8 + F.wave, NGW = F.G * 8;
    const float* gain = fSM(F, SM_FINN);
    f32x4 g[4][2];
#pragma unroll
    for (int j = 0; j < 4; ++j)
#pragma unroll
        for (int h = 0; h < 2; ++h) g[j][h] = *(const f32x4*)(gain + 8 * lane_ + 512 * j + 4 * h);
    for (int row = gw; row < ML; row += NGW) {
        const _Float16* hp = (const _Float16*)(F.ws + WS_H16) + (size_t)row * D + 8 * lane_;
        float* op = F.out + (size_t)row * D + 8 * lane_;
        f32x4 v[4][2]; float ss = 0.f;
#pragma unroll
        for (int j = 0; j < 4; ++j) { h8_to_f32(*(const u32x4*)(hp + 512 * j), v[j][0], v[j][1]);
#pragma unroll
            for (int h = 0; h < 2; ++h) { const f32x4 x = v[j][h]; ss += (x[0] * x[0] + x[1] * x[1]) + (x[2] * x[2] + x[3] * x[3]); } }
        const float rinv = 1.0f / sqrtf(wave_sum(ss, lane_) * (1.0f / D) + EPS);
#pragma unroll
        for (int j = 0; j < 4; ++j)
#pragma unroll
            for (int h = 0; h < 2; ++h) *(f32x4*)(op + 512 * j + 4 * h) = v[j][h] * rinv * g[j][h];
    }
}

__device__ __forceinline__ void attn_phase(Frame& F, int l, bool ctx_out) {
    const int grp = F.vcu >> 3, k8 = F.vcu & 7;
    const bf16_t* Q = (const bf16_t*)(fBIG(F) + BG_Q); const bf16_t* KV = (const bf16_t*)(fBIG(F) + BG_KV); const bf16_t* KR = (const bf16_t*)(fBIG(F) + BG_KR);
    const bf16_t* NQ = (const bf16_t*)(fBIG(F) + BG_NQKV); const bf16_t* NK = NQ + (size_t)MT * 1024; const bf16_t* NV = NK + (size_t)MT * 1024;
    bf16_t* AO = (bf16_t*)(F.ws + WS_AO); float* SSA = (float*)(fBIG(F) + BG_KRF);
#ifndef ATT_ONLY
#define ATT_ONLY 0
#endif
    const int nmla = (ATT_ONLY == 2) ? 0 : 4 + ((ctx_out && F.vcu < 128) ? 1 : 0);
    for (int i = 0; i < nmla; ++i) {
        int b, h, q0, base1, n1;
        if (i < 4) { const int bh = grp + 32 * i; b = bh >> 3; h = bh & 7; q0 = b * SEQ + k8 * 256; base1 = b * SEQ; n1 = 32; }
        else { const int bh = F.vcu; b = bh >> 3; h = bh & 7; q0 = ML + b * CTXL; base1 = 0; n1 = 0; }
        att::attn_unit<192, false>(F.lds, F.wave, Q + (size_t)q0 * QW + h * 192, QW, KV + h * 256, KV + h * 256 + 128, KVW, KR,
                                   base1, n1, ML + b * CTXL, 4, MLA_SCALE, AO + (size_t)q0 * D + h * 128, D, nullptr, 0, 0, SSA + (size_t)q0 * 16 + h);
    }
    const int nna = (ATT_ONLY == 1) ? 0 : 4 + ((ctx_out && F.vcu >= 128) ? 1 : 0);
    for (int i = 0; i < nna; ++i) {
        int b, h, q0, base1, n1, strip0, qgr0;
        if (i < 4) { const int bh = grp + 32 * i; b = bh >> 3; h = bh & 7; const int rg = (k8 + 2 * i) & 7; qgr0 = 4 * rg; q0 = b * SEQ + rg * 256;
            strip0 = min(max(qgr0 - 4, 0), 24); const int send = min(max(qgr0 + 3 - 4, 0), 24) + 8; n1 = send - strip0; base1 = b * SEQ + strip0 * 64; }
        else { const int bh = F.vcu - 128; b = bh >> 3; h = bh & 7; q0 = ML + b * CTXL; base1 = 0; n1 = 0; strip0 = 0; qgr0 = 0; }
        att::attn_unit<128, true>(F.lds, F.wave, NQ + (size_t)q0 * 1024 + h * 128, 1024, NK + h * 128, NV + h * 128, 1024, nullptr,
                                  base1, n1, ML + b * CTXL, 4, NA_SCALE, AO + (size_t)q0 * D + 1024 + h * 128, D, fSM(F, SM_RPB) + (l * 8 + h) * 465, strip0, qgr0, SSA + (size_t)q0 * 16 + 8 + h);
    }
}

__global__ void __launch_bounds__(512, 2) mk_fwd(Args args) {
    extern __shared__ __attribute__((aligned(16))) unsigned char lds_raw[];
    Frame F;
    F.lds = (LAS unsigned char*)lds_raw;
    const int wave0 = __builtin_amdgcn_readfirstlane((int)threadIdx.x >> 6), G0 = gridDim.x, bx0 = blockIdx.x;
    const int vcu0 = (G0 % 8 == 0) ? (bx0 % 8) * (G0 / 8) + bx0 / 8 : bx0;
    F.wave = wave0; F.G = G0; F.vcu = vcu0; F.bx = bx0;
    F.out = args.out; F.ws = args.ws; F.x = args.in[I_X]; F.ctx = args.in[I_CTX];
    volatile LAS unsigned* MISC = (volatile LAS unsigned*)(F.lds + MISC_OFF);
    for (int u = threadIdx.x; u < (LDS_BYTES - LDSCTL_OFF) / 4; u += 512) ((LAS unsigned*)(F.lds + LDSCTL_OFF))[u] = 0u;
    __syncthreads();
    unsigned* ctl = (unsigned*)(args.ws + WS_CTL);
    XcdBarrier bar; bar.bar = ctl + CW_BAR; bar.x = 0; bar.st = nullptr; bar.wave = 0;
    const int lo = args.ph_lo, hi = args.ph_hi;
    const bool use_bar = (hi - lo) > 1;
    if (use_bar) bar = xcd_barrier_post(ctl + CW_BAR, MISC + 8);
    bar.wave = wave0;
#ifndef MK_ONLY
#define MK_ONLY -1
#endif
#define TY(t) (MK_ONLY < 0 || MK_ONLY == (t))
#ifndef MK_REP_TYPE
#define MK_REP_TYPE -1
#endif
#ifndef MK_REP_N
#define MK_REP_N 1
#endif
#define NREP(t) ((MK_REP_TYPE == (t)) ? MK_REP_N : 1)
#define REPEAT(t) for (int rp_ = 0; rp_ < NREP(t); ++rp_)
#define REPBAR() do { if (rp_ > 0) xcd_barrier(bar); } while (0)
#ifndef MK_CVLATE
#define MK_CVLATE 1
#endif
#ifndef MK_FUSEFIN
#define MK_FUSEFIN 1
#endif
#ifndef MK_SPK
#define MK_SPK 1
#endif
#ifndef MK_WGM_SWI
#define MK_WGM_SWI 4
#endif
#ifndef MK_WGM_DOWN
#define MK_WGM_DOWN 4
#endif
#ifndef MK_WGM_WIN
#define MK_WGM_WIN 4
#endif
#ifndef MK_WGM_UP
#define MK_WGM_UP 4
#endif
#ifndef MK_WGM_WOUT
#define MK_WGM_WOUT 4
#endif
#ifndef MK_REP_NULL
#define MK_REP_NULL 0
#endif
#define IN(k) (lo <= (k) && (k) < hi)
#define SEAM(k) do { if (IN(k) && IN((k) + 1)) xcd_barrier(bar); } while (0)
#define FRESH() do { unsigned char* w_ = args.ws; float* o_ = args.out; int wv_ = wave0, vc_ = vcu0, g_ = G0, bx_ = bx0; asm volatile("" : "+s"(w_), "+s"(o_), "+s"(wv_), "+s"(vc_), "+s"(g_), "+s"(bx_)); F.ws = w_; F.out = o_; F.wave = wv_; F.vcu = vc_; F.G = g_; F.bx = bx_; } while (0)
    LAS unsigned char* ring = F.lds;

    if (TY(0) && IN(0)) REPEAT(0) { REPBAR(); FRESH(); p0_prologue(F, args.in); } SEAM(0);
    if (TY(1) && IN(1)) REPEAT(1) { REPBAR(); FRESH(); init_phase(F); } SEAM(1);

#pragma unroll 1
    for (int l = 0; l < DEPTH; ++l) {
        const int pb = 2 + 9 * l; const bool last = (l == DEPTH - 1);
        const bool tailcv = (!last) && (F.G == 256);
        const bool fusefin = MK_FUSEFIN && (F.G == 256) && (MK_REP_TYPE < 0);
        if (l > 0) {
            if (TY(0) && IN(pb - 1)) { FRESH(); if (F.G == 256) { if (!MK_CVLATE) { convert_range(F, args.in, l, CV_W2B, CV_WIN, F.vcu * 8 + F.wave, F.G * 8); convert_range(F, args.in, l, CV_WOUT, CV_ALL, F.vcu * 8 + F.wave, F.G * 8); } }
                else convert_range(F, args.in, l, 0, CV_ALL, F.vcu * 8 + F.wave, F.G * 8);
                __syncthreads(); cvec_layer(F, l); }
            SEAM(pb - 1);
        }
#define TAILCV_AT(thr_, lo_, hi_) do { if (tailcv && F.bx >= (thr_)) convert_range(F, args.in, l + 1, (lo_), (hi_), (F.bx - (thr_)) * 8 + F.wave, (256 - (thr_)) * 8); } while (0)
#define TAILCV_IDLE(lo_, hi_) do { if (tailcv && F.bx >= 128) convert_range(F, args.in, l + 1, (lo_), (hi_), (F.bx - 128) * 8 + F.wave, 1024); } while (0)
#define TAILCV_SPLIT(lo_, hi_) do { if (tailcv) { const int off_ = F.bx >> 3, j_ = ((off_ >> 1) * 8 + (F.bx & 7)) * 8 + F.wave; \
        if (off_ & 1) { convert_range(F, args.in, l + 1, (lo_), (hi_), j_, 3072); convert_range(F, args.in, l + 1, (lo_), (hi_), 1024 + j_, 3072); } else convert_range(F, args.in, l + 1, (lo_), (hi_), 2048 + j_, 3072); } } while (0)
#define SPKSET(ph_) do { if (F.G == 256 && rp_ == 0) { S.spk = F.ws; S.epoch = (ph_) + 1; } } while (0)
#if MK_SPK & 1
#define TAILCV_D TAILCV_SPLIT
#else
#define TAILCV_D TAILCV_IDLE
#endif
#if MK_SPK & 2
#define TAILCV_O TAILCV_SPLIT
#else
#define TAILCV_O TAILCV_IDLE
#endif
#define MODL (fMOD(F) + (size_t)l * 17 * NMOD)
#define SSP ((float*)(F.ws + WS_SS))
#define CBP(s_) ((const float*)(F.ws + WS_CB) + (size_t)l * CB_LAYER + (s_))
        const int Mlate = last ? ML : MT;
        if (TY(2) && IN(pb + 0)) REPEAT(2) { REPBAR(); FRESH(); pg8::Gemm g{fXN(F), (const bf16_t*)wl(F, l, WL_W13A), XNP, D, D}; pg8::Order S; S.init(MT / 256, 2 * DFF / 256, F.G, F.bx, MK_WGM_SWI);
            pg8::EpiSwiGLU E{(bf16_t*)(fBIG(F) + BG_G), DFF, SSP, CBP(CB_S0)}; if (MK_REP_NULL && rp_) { pg8::EpiNull<true> EN; pg8::gemm_phase<pg8::EpiNull<true>, true, true>(ring, F.wave, g, S, EN); } else pg8::gemm_phase<pg8::EpiSwiGLU, true, true>(ring, F.wave, g, S, E); }
        SEAM(pb + 0);
        if (TY(3) && IN(pb + 1)) REPEAT(3) { REPBAR(); FRESH(); pg8::Gemm g{(const bf16_t*)(fBIG(F) + BG_G), (const bf16_t*)wl(F, l, WL_W2A), DFF, DFF, DFF}; pg8::Order S; S.init(MT / 256, D / 256, F.G, F.bx, MK_WGM_DOWN); if (MK_SPK & 1) SPKSET(pb + 1);
            pg8::EpiResid<false> E{F.ws, F.out, l, 2, rp_ ? 0.0f : 0.5f, 1, SM_MIXN + l * D, l, 4, 0};
            if (MK_REP_NULL && rp_) { pg8::EpiNull<true> EN; pg8::gemm_phase<pg8::EpiNull<true>, true, true>(ring, F.wave, g, S, EN); } else pg8::gemm_phase<pg8::EpiResid<false>, true, true, (MK_SPK & 1) != 0>(ring, F.wave, g, S, E);
            if (!(MK_SPK & 1)) TAILCV_IDLE(CV_W13A, CV_W2A); }
        SEAM(pb + 1);
        if (TY(4) && IN(pb + 2)) REPEAT(4) { REPBAR(); FRESH(); pg8::Gemm g{fXN(F), (const bf16_t*)wl(F, l, WL_WIN), XNP, D, D}; pg8::Order S; S.init(MT / 256, PINP / 256, F.G, F.bx, MK_WGM_WIN);
            pg8::EpiWin E{(bf16_t*)(fBIG(F) + BG_CQKV), (bf16_t*)(fBIG(F) + BG_NQKV), (bf16_t*)(fBIG(F) + BG_KR), (float*)(F.ws + WS_RINV), SSP, CBP(CB_S1), (const float*)(F.ws + WS_ROPE)}; pg8::gemm_phase<pg8::EpiWin, true, true>(ring, F.wave, g, S, E);
            if (MK_SPK & 1) TAILCV_AT(144, CV_W13A, CV_W2A);
            if (MK_CVLATE && last && F.G == 256 && F.bx >= 144 && rp_ == 0) convert_range(F, args.in, l, CV_W2B, CV_WIN, (F.bx - 144) * 8 + F.wave, 112 * 8); }
        SEAM(pb + 2);
        if (TY(6) && IN(pb + 3)) REPEAT(6) { REPBAR(); FRESH(); pg8::Gemm g{(const bf16_t*)(fBIG(F) + BG_CQKV), (const bf16_t*)wl(F, l, WL_WUP), 1024, 512, 512}; pg8::Order S; S.init(MT / 256, UPW / 256, F.G, F.bx, MK_WGM_UP, 6, 512);
            const float* cosT = (const float*)(F.ws + WS_ROPE);
            pg8::EpiUp E{(bf16_t*)(fBIG(F) + BG_Q), (bf16_t*)(fBIG(F) + BG_KV), (const float*)(F.ws + WS_RINV), cosT, cosT + 1024}; pg8::gemm_phase<pg8::EpiUp, true, true>(ring, F.wave, g, S, E); }
        SEAM(pb + 3);
        if (TY(7) && IN(pb + 4)) REPEAT(7) { REPBAR(); FRESH(); attn_phase(F, l, !last); }
        SEAM(pb + 4);
        if (TY(3) && IN(pb + 5)) REPEAT(10) { REPBAR(); FRESH(); pg8::Gemm g{(const bf16_t*)(F.ws + WS_AO), (const bf16_t*)wl(F, l, WL_WOUT), D, D, D}; pg8::Order S; S.init(Mlate / 256, D / 256, F.G, F.bx, MK_WGM_WOUT); if (MK_SPK & 2) SPKSET(pb + 5);
            pg8::EpiResid<true> E{F.ws, F.out, l, 5, rp_ ? 0.0f : 1.0f, 1, SM_F2N + l * D, l, 7, 0};
            if (MK_REP_NULL && rp_) { pg8::EpiNull<true> EN; pg8::gemm_phase<pg8::EpiNull<true>, true, true>(ring, F.wave, g, S, EN); } else pg8::gemm_phase<pg8::EpiResid<true>, true, true, (MK_SPK & 2) != 0>(ring, F.wave, g, S, E);
            TAILCV_O(CV_W2A, CV_W13B); TAILCV_O(CV_WUP, CV_WOUT); if (MK_SPK & 1) TAILCV_O(CV_WIN, CV_WUP); }
        SEAM(pb + 5);
        if (TY(2) && IN(pb + 6)) REPEAT(2) { REPBAR(); FRESH(); pg8::Gemm g{fXN(F), (const bf16_t*)wl(F, l, WL_W13B), XNP, D, D}; pg8::Order S; S.init(Mlate / 256, 2 * DFF / 256, F.G, F.bx, MK_WGM_SWI);
            pg8::EpiSwiGLU E{(bf16_t*)(fBIG(F) + BG_G), DFF, SSP, CBP(CB_S2)}; if (MK_REP_NULL && rp_) { pg8::EpiNull<true> EN; pg8::gemm_phase<pg8::EpiNull<true>, true, true>(ring, F.wave, g, S, EN); } else pg8::gemm_phase<pg8::EpiSwiGLU, true, true>(ring, F.wave, g, S, E);
            if (MK_CVLATE && rp_ == 0) TAILCV_AT(192, CV_WOUT, CV_ALL); }
        SEAM(pb + 6);
        if (TY(3) && IN(pb + 7)) REPEAT(3) { REPBAR(); FRESH(); pg8::Gemm g{(const bf16_t*)(fBIG(F) + BG_G), (const bf16_t*)wl(F, l, WL_W2B), DFF, DFF, DFF}; pg8::Order S; S.init(Mlate / 256, D / 256, F.G, F.bx, MK_WGM_DOWN); if (MK_SPK & 1) SPKSET(pb + 7);
            const int ln = last ? l : l + 1;
            pg8::EpiResid<false> E{F.ws, F.out, l, 8, (rp_ && !last) ? 0.0f : 0.5f, last ? 0 : 1, SM_F1N + ln * D, ln, 1, (last && fusefin) ? 1 : 0};
            if (MK_REP_NULL && rp_) { pg8::EpiNull<true> EN; pg8::gemm_phase<pg8::EpiNull<true>, true, true>(ring, F.wave, g, S, EN); } else pg8::gemm_phase<pg8::EpiResid<false>, true, true, (MK_SPK & 1) != 0>(ring, F.wave, g, S, E);
            TAILCV_D(CV_W13B, CV_W2B); if (!(MK_SPK & 1)) TAILCV_D(CV_WIN, CV_WUP); }
        if (!(last && fusefin)) SEAM(pb + 7);
    }
    if (TY(9) && IN(NPHASE - 1) && !(MK_FUSEFIN && (F.G == 256) && (MK_REP_TYPE < 0))) { FRESH(); final_phase(F); }
#undef IN
#undef SEAM
}

#if MK_DEBUG
__device__ __forceinline__ double dbf(bf16_t b) { return (double)__builtin_bit_cast(float, ((unsigned)b) << 16); }
__device__ __forceinline__ unsigned hsh(unsigned x) { x ^= x >> 16; x *= 0x7feb352du; x ^= x >> 15; x *= 0x846ca68bu; x ^= x >> 16; return x; }
__device__ __forceinline__ double dsilu(double x) { return x / (1.0 + exp(-x)); }
__device__ __forceinline__ double dh16(const _Float16* p) { return (double)(float)*p; }
struct DbgLoc { const void* p; int isbf; float atol; };
__device__ void dbg_sample(const Args& a, int ph, int s, double& expv, DbgLoc& loc) {
    const unsigned char* ws = a.ws; const float* const* in = a.in;
    const float* MOD = (const float*)(ws + WS_MOD); const _Float16* H16 = (const _Float16*)(ws + WS_H16); const bf16_t* XN = (const bf16_t*)(ws + WS_XN); const unsigned char* BIG = ws + WS_BIG;
    const unsigned h1 = hsh(s * 2654435761u + ph * 97u + 1u), h2 = hsh(h1 + 0x9e3779b9u), h3 = hsh(h2 + 77u);
    loc.atol = 0.02f; loc.isbf = 1; loc.p = nullptr; expv = 0.0;
    if (ph == 0) { const int l = h1 & 1, r = h2 % 17, n = h3 % NMOD; double acc = in[I_ADAB][l * NMOD + n];
        for (int k = 0; k < D; ++k) { const double c = (r < 16) ? in[I_C][r * D + k] : in[I_CCTX][k]; acc += dsilu(c) * (double)in[I_ADAW][((size_t)l * D + k) * NMOD + n]; }
        expv = acc; loc.p = MOD + ((size_t)l * 17 + r) * NMOD + n; loc.isbf = 0; loc.atol = 0.002f; return; }
    if (ph == NPHASE - 1) { const int row = h1 % ML, col = h2 % D; const _Float16* hp = H16 + (size_t)row * D; double ss = 0; for (int k = 0; k < D; ++k) ss += dh16(hp + k) * dh16(hp + k);
        expv = dh16(hp + col) / sqrt(ss / D + 1e-6) * in[I_FINN][col]; loc.p = a.out + (size_t)row * D + col; loc.isbf = 0; loc.atol = 0.002f; return; }
    if (ph == 1 || ph == 10) {
        const int l = (ph == 1) ? 0 : 1, s = h2 % 3, b = h3 % 17; const int N = (s == 1) ? PINP : 2 * DFF; const int n = hsh(h3 + 5u) % N;
        const bf16_t* Wt = (const bf16_t*)(ws + WS_W + (s == 0 ? WL_W13A : s == 1 ? WL_WIN : WL_W13B)) + (size_t)n * D;
        double acc = 0; for (int k = 0; k < D; ++k) acc += (double)MOD[((size_t)l * 17 + b) * NMOD + 3 * s * D + k] * dbf(Wt[k]);
        expv = acc; loc.p = (const float*)(ws + WS_CB) + (size_t)l * CB_LAYER + (s == 0 ? CB_S0 : s == 1 ? CB_S1 : CB_S2) + (size_t)b * N + n; loc.isbf = 0; loc.atol = 0.002f; return; }
    const int l = (ph < 10) ? 0 : 1; int st = (ph < 10) ? ph - 2 : ph - 11; if (st >= 3) st += 1; if (st >= 6) st += 1;
    const bool last = (l == DEPTH - 1);
    const float* modl = MOD + (size_t)l * 17 * NMOD;
    const int Mlate = last ? ML : MT;
    const bf16_t* AO = (const bf16_t*)(ws + WS_AO);
    auto pickrow = [&](int M) -> int { const int q = s & 7; if (q == 0) return 0; if (q == 1) return M - 1; if (q == 2 && M > ML) return ML + (int)(h1 % MC); return (int)(h1 % (unsigned)M); };
    if (st == 0 || st == 8 || st == 2) {
        const int M = (st == 8) ? Mlate : MT; const int row = pickrow(M); const int b = row < ML ? row >> 11 : 16;
        const _Float16* hp = H16 + (size_t)row * D; const float* gain = in[st == 0 ? I_F1N : st == 2 ? I_MIXN : I_F2N] + l * D; const int si = st == 0 ? 0 : st == 2 ? 3 : 6;
        double ss = 0; for (int q = 0; q < D; ++q) ss += dh16(hp + q) * dh16(hp + q);
        const double rinv = 1.0 / sqrt(ss / D + 1e-6);
        if (st == 2) {
            const float* w = in[I_WIN] + (size_t)l * D * PIN;
            auto dotc = [&](int c) -> double { double x = 0; for (int k = 0; k < D; ++k) { const double xn = dh16(hp + k) * rinv * gain[k] * (1.0 + modl[(size_t)b * NMOD + (si + 1) * D + k]) + modl[(size_t)b * NMOD + si * D + k]; x += xn * w[(size_t)k * PIN + c]; } return x; };
            if ((s & 15) == 5) {
                const int pn = h2 & 3; double ss2 = 0; for (int c = 0; c < 256; ++c) { const double v = dotc(pn * 256 + c); ss2 += v * v; }
                expv = ss2; loc.p = (const float*)(ws + WS_RINV) + (size_t)row * 4 + pn; loc.isbf = 0; loc.atol = 0.5f; return; }
            const int c = h2 % PIN;
            if (c >= 1024 && c < 1088) { const int j = c - 1024, axis = j >> 5, half = (j >> 4) & 1, f = j & 15; const double xa = dotc(1024 + axis * 32 + f), xb = dotc(1024 + axis * 32 + 16 + f); double v;
                if (row < ML) { const int t = row & (SEQ - 1); const double pos = axis ? (t & 63) : (t >> 6); const double ang = pos * (double)powf(10000.f, -(float)f / 16.f); v = half ? xa * sin(ang) + xb * cos(ang) : xa * cos(ang) - xb * sin(ang); }
                else v = half ? xb : xa;
                expv = v; loc.p = (const bf16_t*)(BIG + BG_KR) + (size_t)row * 64 + axis * 32 + 8 * (f >> 2) + 4 * half + (f & 3); return; }
            expv = dotc(c);
            if (c < 1024) loc.p = (const bf16_t*)(BIG + BG_CQKV) + (size_t)row * 1024 + c;
            else { const int cc = c - 1088; loc.p = (const bf16_t*)(BIG + BG_NQKV) + (size_t)(cc >> 10) * MT * 1024 + (size_t)row * 1024 + (cc & 1023); }
            return; }
        const int j = h2 % DFF; const float* w1 = in[st == 0 ? I_F1W1 : I_F2W1] + (size_t)l * D * DFF; const float* w3 = in[st == 0 ? I_F1W3 : I_F2W3] + (size_t)l * D * DFF;
        double x = 0, y = 0;
        for (int k = 0; k < D; ++k) { const double xn = dh16(hp + k) * rinv * gain[k] * (1.0 + modl[(size_t)b * NMOD + (si + 1) * D + k]) + modl[(size_t)b * NMOD + si * D + k]; x += xn * w1[(size_t)k * DFF + j]; y += xn * w3[(size_t)k * DFF + j]; }
        expv = dsilu(x) * y; loc.p = (const bf16_t*)(BIG + BG_G) + (size_t)row * DFF + j; return; }
    if (st == 1 || st == 9) {
        const int M = (st == 9) ? Mlate : MT; const int row = pickrow(M), col = h2 % D; const int b = row < ML ? row >> 11 : 16; const float* w2 = in[st == 1 ? I_F1W2 : I_F2W2] + (size_t)l * DFF * D;
        const bf16_t* G = (const bf16_t*)(BIG + BG_G) + (size_t)row * DFF; double x = 0; for (int k = 0; k < DFF; ++k) x += dbf(G[k]) * w2[(size_t)k * D + col];
        expv = dh16(H16 + (size_t)row * D + col) + 0.5 * modl[(size_t)b * NMOD + (st == 1 ? 2 : 8) * D + col] * x;
        loc.p = H16 + (size_t)row * D + col; loc.isbf = 2; loc.atol = 0.004f; return; }
    if (st == 4) {
        const int row = pickrow(MT), idx = h2 % UPW; const bf16_t* cq = (const bf16_t*)(BIG + BG_CQKV) + (size_t)row * 1024; const float* sq4 = (const float*)(ws + WS_RINV) + (size_t)row * 4;
        const double rq_ = 1.0 / sqrt(((double)sq4[0] + sq4[1]) / 512 + 1e-6), rkv_ = 1.0 / sqrt(((double)sq4[2] + sq4[3]) / 512 + 1e-6);
        if (idx >= QW) { const int c = idx - QW; const float* w = in[I_WUKV] + (size_t)l * 512 * KVW; const float* gn = in[I_KVAN] + l * 512; double x = 0; for (int k = 0; k < 512; ++k) x += dbf(cq[512 + k]) * gn[k] * w[(size_t)k * KVW + c];
            expv = x * rkv_; loc.p = (const bf16_t*)(BIG + BG_KV) + (size_t)row * KVW + c; return; }
        const int h = idx / 192, d = idx % 192; const float* w = in[I_WUQ] + (size_t)l * 512 * QW; const float* gn = in[I_QAN] + l * 512;
        auto qv = [&](int dd) -> double { double x = 0; for (int k = 0; k < 512; ++k) x += dbf(cq[k]) * gn[k] * w[(size_t)k * QW + h * 192 + dd]; return x * rq_; };
        if (d < 128) { expv = qv(d); loc.p = (const bf16_t*)(BIG + BG_Q) + (size_t)row * QW + h * 192 + d; return; }
        const int j = d - 128, axis = j >> 5, half = (j >> 4) & 1, f = j & 15; const double xa = qv(128 + axis * 32 + f), xb = qv(128 + axis * 32 + 16 + f); double v;
        if (row < ML) { const int t = row & (SEQ - 1); const double pos = axis ? (t & 63) : (t >> 6); const double ang = pos * (double)powf(10000.f, -(float)f / 16.f); v = half ? xa * sin(ang) + xb * cos(ang) : xa * cos(ang) - xb * sin(ang); }
        else v = half ? xb : xa;
        expv = v; loc.p = (const bf16_t*)(BIG + BG_Q) + (size_t)row * QW + h * 192 + 128 + axis * 32 + 8 * (f >> 2) + 4 * half + (f & 3); return; }
    if (st == 7) {
        const int row = pickrow(Mlate), col = h2 % D; const int b = row < ML ? row >> 11 : 16; const float* w = in[I_WOUT] + (size_t)l * D * D; const bf16_t* ao = AO + (size_t)row * D;
        double sa = 0, sb = 0; for (int k = 0; k < 1024; ++k) { const double va = dbf(ao[k]), vb = dbf(ao[1024 + k]); sa += va * va; sb += vb * vb; }
        const double ra = 1.0 / sqrt(sa / 1024 + 1e-6), rb = 1.0 / sqrt(sb / 1024 + 1e-6); double x = 0;
        for (int k = 0; k < D; ++k) x += dbf(ao[k]) * (k < 1024 ? ra : rb) * in[I_OUTN][l * D + k] * w[(size_t)k * D + col];
        expv = dh16(H16 + (size_t)row * D + col) + (double)modl[(size_t)b * NMOD + 5 * D + col] * x; loc.p = H16 + (size_t)row * D + col; loc.isbf = 2; loc.atol = 0.004f; return; }
    (void)XN;
}
__global__ void dbg_attn(Args a, int ph, int mode) {
    __shared__ float sc[2560]; __shared__ float red[2];
    const int l = (ph < 10) ? 0 : 1; const bool last = (l == DEPTH - 1);
    const unsigned char* BIG = a.ws + WS_BIG; const bf16_t* XN = (const bf16_t*)(a.ws + WS_AO);
    unsigned* dw = (unsigned*)(a.ws + WS_CTL) + CW_DBG + ph * 4; float* EXPB = (float*)(a.ws + WS_DBG);
    const int s = blockIdx.x, d = threadIdx.x;
    const unsigned h1 = hsh(s * 2654435761u + 12345u), h2 = hsh(h1 + 99u);
    const bool wantctx = (!last) && ((s & 7) == 3);
    const int row = wantctx ? ML + (int)(h1 % MC) : ((s & 7) == 0 ? (int)((h1 % NBATCH) * SEQ) : (s & 7) == 1 ? (int)((h1 % NBATCH) * SEQ + SEQ - 1) : (int)(h1 % ML));
    const int grpB = (h2 >> 3) & 1, h = h2 & 7;
    const int b = row < ML ? row >> 11 : (row - ML) >> 8;
    const bf16_t* AOp = XN + (size_t)row * D + (grpB ? 1024 : 0) + h * 128 + d;
    if (mode == 1) { const float ev = EXPB[s * 128 + d]; const float av = __builtin_bit_cast(float, ((unsigned)*AOp) << 16); const float ratio = fabsf(av - ev) / (0.02f * fabsf(ev) + 0.003f);
        if (!(ratio <= 1.0f)) atomicAdd(dw, 1u); atomicMax(dw + 1, __float_as_uint(ratio == ratio ? ratio : 1e30f)); return; }
    const int nlat = row < ML ? (grpB ? 512 : 2048) : 0; const int nk = nlat + 256;
    const int t = row & (SEQ - 1), gr = t >> 6, qc = t & 63, rs = min(max(gr - 4, 0), 24), cs0 = min(max(qc - 8, 0), 48);
    const bf16_t* Q = (const bf16_t*)(BIG + BG_Q); const bf16_t* KV = (const bf16_t*)(BIG + BG_KV); const bf16_t* KR = (const bf16_t*)(BIG + BG_KR);
    const bf16_t* NQ = (const bf16_t*)(BIG + BG_NQKV); const bf16_t* NK = NQ + (size_t)MT * 1024; const bf16_t* NV = NK + (size_t)MT * 1024;
    for (int k = d; k < nk; k += 128) {
        int krow; bool valid = true; double bias = 0;
        if (k < nlat) { if (grpB) { const int kr = rs + (k >> 6), kc = k & 63; krow = b * SEQ + kr * 64 + kc; valid = (kc >= cs0) && (kc < cs0 + 16); if (valid) bias = a.in[I_RPB][((size_t)(l * 8 + h) * 15 + (kr - gr + 7)) * 31 + (kc - qc + 15)]; } else krow = b * SEQ + k; }
        else krow = ML + b * CTXL + (k - nlat);
        double x = 0;
        if (!grpB) { for (int q = 0; q < 128; ++q) x += dbf(Q[(size_t)row * QW + h * 192 + q]) * dbf(KV[(size_t)krow * KVW + h * 256 + q]); for (int q = 0; q < 64; ++q) x += dbf(Q[(size_t)row * QW + h * 192 + 128 + q]) * dbf(KR[(size_t)krow * 64 + q]); x *= (double)MLA_SCALE; }
        else { for (int q = 0; q < 128; ++q) x += dbf(NQ[(size_t)row * 1024 + h * 128 + q]) * dbf(NK[(size_t)krow * 1024 + h * 128 + q]); x = x * (double)NA_SCALE + bias; }
        sc[k] = valid ? (float)x : -1e30f;
    }
    __syncthreads();
    float mx = -1e30f; for (int k = 0; k < nk; ++k) mx = fmaxf(mx, sc[k]);
    double den = 0, acc = 0;
    for (int k = 0; k < nk; ++k) { const double p = exp((double)sc[k] - (double)mx); if (sc[k] < -1e29f) continue; den += p;
        int krow; if (k < nlat) krow = grpB ? b * SEQ + (rs + (k >> 6)) * 64 + (k & 63) : b * SEQ + k; else krow = ML + b * CTXL + (k - nlat);
        acc += p * (grpB ? dbf(NV[(size_t)krow * 1024 + h * 128 + d]) : dbf(KV[(size_t)krow * KVW + h * 256 + 128 + d])); }
    EXPB[s * 128 + d] = (float)(acc / den);
    (void)red;
}
__global__ void dbg_check(Args a, int ph, int mode) {
    const int s = blockIdx.x * blockDim.x + threadIdx.x;
    unsigned* dw = (unsigned*)(a.ws + WS_CTL) + CW_DBG + ph * 4; float* EXPB = (float*)(a.ws + WS_DBG);
    double ev; DbgLoc loc; dbg_sample(a, ph, s, ev, loc);
    if (!loc.p) return;
    if (mode == 0) { EXPB[s] = (float)ev; return; }
    const float e = EXPB[s]; const float av = loc.isbf == 1 ? __builtin_bit_cast(float, ((unsigned)*(const bf16_t*)loc.p) << 16) : loc.isbf == 2 ? (float)*(const _Float16*)loc.p : *(const float*)loc.p;
    const float ratio = fabsf(av - e) / (0.02f * fabsf(e) + loc.atol);
    if (!(ratio <= 1.0f)) atomicAdd(dw, 1u);
    atomicMax(dw + 1, __float_as_uint(ratio == ratio ? ratio : 1e30f));
}
__global__ void dbg_report(Args a) {
    const unsigned* dw = (const unsigned*)(a.ws + WS_CTL) + CW_DBG; int bad = -1; float ratio = 0;
    for (int p = 0; p < NPHASE; ++p) if (dw[p * 4] != 0u) { bad = p; ratio = __uint_as_float(dw[p * 4 + 1]); break; }
    if (bad < 0) return;
    float e = 10.f * log10f(fmaxf(ratio, 1e-3f)) + 10.f; e = fminf(fmaxf(rintf(e), 1.f), 99.f);
    const float v = 1e4f * sqrtf(e);
    for (size_t i = (size_t)blockIdx.x * blockDim.x + threadIdx.x; i < (size_t)ML * D; i += (size_t)gridDim.x * blockDim.x) a.out[i] = (i == 0) ? 1e6f * (float)(bad + 1) : v;
}
#endif

extern "C" void kernel_launch(void* const* d_in, const int* in_sizes, int n_in, void* d_out, int out_size, void* d_ws, size_t ws_size, hipStream_t stream) {
    static int grid = 0;
    if (grid == 0) {
        if (n_in != 24 || in_sizes[0] != ML * D || out_size != ML * D || ws_size < WS_END) { fprintf(stderr, "kernel_launch: built for 24 inputs, x/out of %d floats, >= %zu bytes of workspace; got n_in %d, in0 %d, out %d, ws %zu; nothing launched\n", ML * D, (size_t)WS_END, n_in, n_in > 0 ? in_sizes[0] : -1, out_size, ws_size); grid = -1; return; }
        int dev = 0, cus = 0, per_cu = 0;
        if (hipGetDevice(&dev) != hipSuccess || hipDeviceGetAttribute(&cus, hipDeviceAttributeMultiprocessorCount, dev) != hipSuccess) { fprintf(stderr, "kernel_launch: device query failed\n"); grid = -1; return; }
        if (hipFuncSetAttribute((const void*)mk_fwd, hipFuncAttributeMaxDynamicSharedMemorySize, LDS_BYTES) != hipSuccess) { fprintf(stderr, "kernel_launch: hipFuncSetAttribute failed\n"); grid = -1; return; }
        if (hipOccupancyMaxActiveBlocksPerMultiprocessor(&per_cu, (const void*)mk_fwd, 512, LDS_BYTES) != hipSuccess || per_cu < 1) fprintf(stderr, "kernel_launch: note: occupancy query reports %d workgroups per CU\n", per_cu);
        (void)hipGetLastError();
        grid = cus;
    }
    if (grid < 0) return;
    if (hipMemsetAsync((char*)d_ws + WS_CTL, 0, CTL_ZERO_BYTES, stream) != hipSuccess) { fprintf(stderr, "kernel_launch: memset failed\n"); return; }
    Args a{};
    for (int i = 0; i < 24; ++i) a.in[i] = (const float*)d_in[i];
    a.out = (float*)d_out; a.ws = (unsigned char*)d_ws;
#if MK_PER_PHASE || MK_DEBUG
    for (int ph = 0; ph < NPHASE; ++ph) {
#if MK_DEBUG
        const bool isattn = (ph == 6 || ph == 15);
        if (isattn) hipLaunchKernelGGL(dbg_attn, dim3(64), dim3(128), 0, stream, a, ph, 0); else hipLaunchKernelGGL(dbg_check, dim3(16), dim3(64), 0, stream, a, ph, 0);
#endif
        a.ph_lo = ph; a.ph_hi = ph + 1;
        hipLaunchKernelGGL(mk_fwd, dim3(grid), dim3(512), LDS_BYTES, stream, a);
#if MK_DEBUG
        if (isattn) hipLaunchKernelGGL(dbg_attn, dim3(64), dim3(128), 0, stream, a, ph, 1); else hipLaunchKernelGGL(dbg_check, dim3(16), dim3(64), 0, stream, a, ph, 1);
#endif
    }
#if MK_DEBUG
    hipLaunchKernelGGL(dbg_report, dim3(1024), dim3(256), 0, stream, a);
#endif
#else
    a.ph_lo = 0; a.ph_hi = NPHASE;
    hipLaunchKernelGGL(mk_fwd, dim3(grid), dim3(512), LDS_BYTES, stream, a);
#endif
    const hipError_t le = hipPeekAtLastError();
    if (le != hipSuccess) fprintf(stderr, "kernel_launch: launch failed: %s\n", hipGetErrorName(le));
}
```
